# Optimizing an MI355X kernel written in HIP

```python
import math
import jax, jax.numpy as jnp
from jax import lax
import numpy as np

D_MODEL = 1024
BATCH = 4
SEQ = 4096
DEPTH = 2

GRID_W = 64
CTX_LEN = 256
HEAD_DIM = 64
D_FF = 2816
N_MOD = 9
RMS_EPS = 1e-6
RWKV_WIDTH = D_MODEL // 2
RWKV_HEADS = RWKV_WIDTH // HEAD_DIM
RWKV_DECAY_LORA = 64
RWKV_ICLR_LORA = 64
RWKV_GATE_LORA = 128
RWKV_PROJ = 3 * RWKV_WIDTH + RWKV_DECAY_LORA + RWKV_ICLR_LORA + RWKV_GATE_LORA
GN_EPS = 64e-5
S5_WIDTH = D_MODEL - RWKV_WIDTH
S5_GROUP_CH = 16
S5_GROUPS = S5_WIDTH // S5_GROUP_CH
S5_STATE = 64
AB_PROJ = RWKV_PROJ + S5_WIDTH
ATTN_HEADS = D_MODEL // HEAD_DIM
ATTN_KV_HEADS = 4
ATTN_GROUP = ATTN_HEADS // ATTN_KV_HEADS
ATTN_WINDOW = 128
ATTN_BLOCK = 128
ATTN_Q_W = ATTN_HEADS * HEAD_DIM
ATTN_KV_W = ATTN_KV_HEADS * HEAD_DIM
C_PROJ = ATTN_Q_W + 2 * ATTN_KV_W
ROPE_AXIS_DIM = HEAD_DIM // 2
ROPE_BASE = 10000.0
NEG_INF = -1e30

kernel_name = "hybrid_rwkv7_s5_swa_macaron_dit"


def _rmsnorm(h, g):
    h32 = h.astype(jnp.float32)
    h32 = h32 * lax.rsqrt(jnp.mean(h32 * h32, axis=-1, keepdims=True) + RMS_EPS)
    return (h32 * g).astype(h.dtype)


def _modnorm(h, g, shift, scale):
    return _rmsnorm(h, g) * (1.0 + scale) + shift


def _swiglu(h, w1, w2):
    gate, up = jnp.split(h @ w1, 2, axis=-1)
    return (jax.nn.silu(gate) * up) @ w2


def _shift_mix(p, mu_prev, mu_next):
    prev = jnp.pad(p[:, :-1], ((0, 0), (1, 0), (0, 0)))
    nxt = jnp.pad(p[:, 1:], ((0, 0), (0, 1), (0, 0)))
    return p + mu_prev * (prev - p) + mu_next * (nxt - p)


def _rwkv_scan(seq, reverse):
    bsz = seq[0].shape[1]

    def step(state, inp):
        r_t, w_t, k_t, v_t, a_t, b_t = inp
        sa = jnp.einsum('bhvk,bhk->bhv', state, a_t)
        state = state * w_t[:, :, None, :] + sa[..., None] * b_t[:, :, None, :] + v_t[..., None] * k_t[:, :, None, :]
        return state, jnp.einsum('bhvk,bhk->bhv', state, r_t)

    s0 = jnp.zeros((bsz, RWKV_HEADS, HEAD_DIM, HEAD_DIM), jnp.float32)
    _, y = lax.scan(step, s0, seq, reverse=reverse)
    return y


def _rwkv7(p, lc, w0, w2, a0, a2, g2, k_k, k_a, r_k, lnx_g, lnx_b):
    f32 = jnp.float32
    p = p.astype(f32)
    bsz, L, _ = p.shape
    W = RWKV_WIDTH
    r, k, v, wl, al, gl = jnp.split(
        p, [W, 2 * W, 3 * W, 3 * W + RWKV_DECAY_LORA, 3 * W + RWKV_DECAY_LORA + RWKV_ICLR_LORA], axis=-1)
    heads = lambda t: t.reshape(bsz, L, RWKV_HEADS, HEAD_DIM)
    tm = lambda t: jnp.swapaxes(t, 0, 1)
    kk = heads(k * k_k)
    kk = kk * lax.rsqrt(jnp.maximum(jnp.sum(kk * kk, axis=-1, keepdims=True), 1e-12))
    tanh_wl = jnp.tanh(wl)
    r_h, v_h = heads(r), heads(v)
    y = 0.0
    k_sum = 0.0
    for d in range(2):
        w = -jax.nn.softplus(-(w0[d] + tanh_wl @ w2[d])) - 0.5
        decay = jnp.exp(-jnp.exp(w))
        a = jax.nn.sigmoid(a0[d] + al @ a2[d])
        kd = heads(k * (1.0 + (a - 1.0) * k_a))
        seq = tuple(tm(t) for t in (r_h, heads(decay), kd, v_h, -kk, kk * heads(a)))
        if d == 1:
            seq = tuple(jnp.roll(t, -lc, axis=0) for t in seq)
        yd = _rwkv_scan(seq, reverse=(d == 1))
        if d == 1:
            yd = jnp.roll(yd, lc, axis=0)
        y = y + yd
        k_sum = k_sum + kd
    y = jnp.swapaxes(y, 0, 1)
    mu = jnp.mean(y, axis=-1, keepdims=True)
    var = jnp.mean(jnp.square(y - mu), axis=-1, keepdims=True)
    y = (y - mu) * lax.rsqrt(var + GN_EPS) * lnx_g.reshape(RWKV_HEADS, HEAD_DIM) + lnx_b.reshape(RWKV_HEADS, HEAD_DIM)
    bonus = jnp.sum(r_h * (0.5 * k_sum) * r_k, axis=-1, keepdims=True) * v_h
    g = jax.nn.sigmoid(gl) @ g2
    return (y + bonus).reshape(bsz, L, W) * g


def _complex_affine_combine(e1, e2):
    a1r, a1i, b1r, b1i = e1
    a2r, a2i, b2r, b2i = e2
    return (a2r * a1r - a2i * a1i, a2r * a1i + a2i * a1r,
            a2r * b1r - a2i * b1i + b2r, a2r * b1i + a2i * b1r + b2i)


def _s5_scan(u_tm, a_re, a_im, log_step, b_re, b_im, c_re, c_im, reverse):
    f32 = jnp.float32
    lam_re = jnp.minimum(a_re.astype(f32), -1e-4)
    lam_im = a_im.astype(f32)
    dt = jnp.exp(log_step.astype(f32))[:, None]
    mag = jnp.exp(lam_re * dt)
    ab_re, ab_im = mag * jnp.cos(lam_im * dt), mag * jnp.sin(lam_im * dt)
    den = lam_re * lam_re + lam_im * lam_im
    f_re = ((ab_re - 1.0) * lam_re + ab_im * lam_im) / den
    f_im = (ab_im * lam_re - (ab_re - 1.0) * lam_im) / den
    b_re, b_im = b_re.astype(f32), b_im.astype(f32)
    bb_re = f_re[..., None] * b_re - f_im[..., None] * b_im
    bb_im = f_re[..., None] * b_im + f_im[..., None] * b_re
    bu_re = jnp.einsum('tbgi,gpi->tbgp', u_tm, bb_re)
    bu_im = jnp.einsum('tbgi,gpi->tbgp', u_tm, bb_im)
    L = u_tm.shape[0]
    a_re_t = jnp.broadcast_to(ab_re, (L, 1) + ab_re.shape)
    a_im_t = jnp.broadcast_to(ab_im, (L, 1) + ab_im.shape)
    _, _, x_re, x_im = lax.associative_scan(
        _complex_affine_combine, (a_re_t, a_im_t, bu_re, bu_im), reverse=reverse, axis=0)
    return (jnp.einsum('tbgp,gip->tbgi', x_re, c_re.astype(f32))
            - jnp.einsum('tbgp,gip->tbgi', x_im, c_im.astype(f32)))


def _s5(u, lc, a_re, a_im, log_step, b_re, b_im, c_re, c_im, d_skip, glu_w, glu_b):
    u = u.astype(jnp.float32)
    bsz, L, _ = u.shape
    u_tm = jnp.swapaxes(u.reshape(bsz, L, S5_GROUPS, S5_GROUP_CH), 0, 1)
    y_f = _s5_scan(u_tm, a_re[0], a_im[0], log_step[0], b_re[0], b_im[0], c_re[0], c_im[0], reverse=False)
    y_b = jnp.roll(_s5_scan(jnp.roll(u_tm, -lc, axis=0), a_re[1], a_im[1], log_step[1],
                            b_re[1], b_im[1], c_re[1], c_im[1], reverse=True), lc, axis=0)
    y = jnp.swapaxes(y_f + y_b, 0, 1).reshape(bsz, L, S5_WIDTH) + d_skip * u
    z = jax.nn.gelu(y)
    return z * jax.nn.sigmoid(z @ glu_w + glu_b)


def _mixer_ab(h_lat, h_ctx, in_w, out_w, mu, w0, w2, a0, a2, g2, k_k, k_a, r_k, lnx_g, lnx_b,
              s_are, s_aim, s_step, s_bre, s_bim, s_cre, s_cim, s_d, glu_w, glu_b):
    lc = h_ctx.shape[1]
    p = jnp.concatenate([h_ctx, h_lat], axis=1) @ in_w
    pa, pb = p[..., :RWKV_PROJ], p[..., RWKV_PROJ:]
    pa = jnp.concatenate([_shift_mix(pa[:, :lc], mu[0], mu[1]), _shift_mix(pa[:, lc:], mu[0], mu[1])], axis=1)
    ya = _rwkv7(pa, lc, w0, w2, a0, a2, g2, k_k, k_a, r_k, lnx_g, lnx_b)
    yb = _s5(pb, lc, s_are, s_aim, s_step, s_bre, s_bim, s_cre, s_cim, s_d, glu_w, glu_b)
    y = jnp.concatenate([ya, yb], axis=-1) @ out_w
    return y[:, lc:], y[:, :lc]


def _rope(t, cos, sin):
    half = HEAD_DIM // 2
    t1, t2 = t[..., :half], t[..., half:]
    cs, sn = cos[None, :, None, :], sin[None, :, None, :]
    return jnp.concatenate([t1 * cs - t2 * sn, t2 * cs + t1 * sn], axis=-1)


def _window_attention(q, k, v, kc, vc, sink):
    f32 = jnp.float32
    bsz, n, _, _ = q.shape
    lc = kc.shape[1]
    nb = n // ATTN_BLOCK
    qb = q.reshape(bsz, nb, ATTN_BLOCK, ATTN_KV_HEADS, ATTN_GROUP, HEAD_DIM)
    pad = ((0, 0), (ATTN_BLOCK, ATTN_BLOCK), (0, 0), (0, 0))
    kp = jnp.pad(k, pad).reshape(bsz, nb + 2, ATTN_BLOCK, ATTN_KV_HEADS, HEAD_DIM)
    vp = jnp.pad(v, pad).reshape(bsz, nb + 2, ATTN_BLOCK, ATTN_KV_HEADS, HEAD_DIM)
    kw = jnp.concatenate([kp[:, :-2], kp[:, 1:-1], kp[:, 2:]], axis=2)
    vw = jnp.concatenate([vp[:, :-2], vp[:, 1:-1], vp[:, 2:]], axis=2)
    qi = jnp.arange(ATTN_BLOCK)[:, None]
    mj = jnp.arange(3 * ATTN_BLOCK)[None, :] - ATTN_BLOCK
    kj = jnp.arange(nb)[:, None, None] * ATTN_BLOCK + mj[None]
    valid = (jnp.abs(mj - qi)[None] <= ATTN_WINDOW) & (kj >= 0) & (kj < n)
    sink_l = sink.astype(f32).reshape(ATTN_KV_HEADS, ATTN_GROUP)[None, :, :, None, None]
    scale = HEAD_DIM ** -0.5
    m_win = 3 * ATTN_BLOCK

    def one_block(args):
        qblk, kblk, vblk, vmask = args
        s_win = jnp.einsum('bqkgd,bmkd->bkgqm', qblk, kblk).astype(f32) * scale
        s_win = jnp.where(vmask, s_win, NEG_INF)
        s_ctx = jnp.einsum('bqkgd,bckd->bkgqc', qblk, kc).astype(f32) * scale
        s_sink = jnp.broadcast_to(sink_l, s_win.shape[:-1] + (1,))
        prob = jax.nn.softmax(jnp.concatenate([s_win, s_ctx, s_sink], axis=-1), axis=-1)
        return (jnp.einsum('bkgqm,bmkd->bqkgd', prob[..., :m_win], vblk)
                + jnp.einsum('bkgqc,bckd->bqkgd', prob[..., m_win:m_win + lc], vc))

    out = lax.map(one_block, (jnp.moveaxis(qb, 1, 0), jnp.moveaxis(kw, 1, 0), jnp.moveaxis(vw, 1, 0), valid))
    return jnp.moveaxis(out, 0, 1).reshape(bsz, n, ATTN_Q_W)


def _context_attention(qc, kc, vc, sink):
    f32 = jnp.float32
    bsz, lc = qc.shape[:2]
    qg = qc.reshape(bsz, lc, ATTN_KV_HEADS, ATTN_GROUP, HEAD_DIM)
    s = jnp.einsum('bckgd,bjkd->bkgcj', qg, kc).astype(f32) * HEAD_DIM ** -0.5
    s_sink = jnp.broadcast_to(sink.astype(f32).reshape(ATTN_KV_HEADS, ATTN_GROUP)[None, :, :, None, None],
                              s.shape[:-1] + (1,))
    prob = jax.nn.softmax(jnp.concatenate([s, s_sink], axis=-1), axis=-1)
    o = jnp.einsum('bkgcj,bjkd->bckgd', prob[..., :lc], vc)
    return o.reshape(bsz, lc, ATTN_Q_W)


def _mixer_c(h_lat, h_ctx, in_w, out_w, sink, cos, sin, need_ctx):
    bsz, n, _ = h_lat.shape
    lc = h_ctx.shape[1]
    p = h_lat @ in_w
    q = _rope(p[..., :ATTN_Q_W].reshape(bsz, n, ATTN_HEADS, HEAD_DIM), cos, sin)
    k = _rope(p[..., ATTN_Q_W:ATTN_Q_W + ATTN_KV_W].reshape(bsz, n, ATTN_KV_HEADS, HEAD_DIM), cos, sin)
    v = p[..., ATTN_Q_W + ATTN_KV_W:].reshape(bsz, n, ATTN_KV_HEADS, HEAD_DIM)
    pc = h_ctx @ in_w[:, ATTN_Q_W:]
    kc = pc[..., :ATTN_KV_W].reshape(bsz, lc, ATTN_KV_HEADS, HEAD_DIM)
    vc = pc[..., ATTN_KV_W:].reshape(bsz, lc, ATTN_KV_HEADS, HEAD_DIM)
    y_lat = _window_attention(q, k, v, kc, vc, sink) @ out_w
    if not need_ctx:
        return y_lat, None
    qc = (h_ctx @ in_w[:, :ATTN_Q_W]).reshape(bsz, lc, ATTN_HEADS, HEAD_DIM)
    return y_lat, _context_attention(qc, kc, vc, sink) @ out_w


def setup_inputs(seed: int = 0) -> dict:
    key = jax.random.key(seed)
    ks = iter(jax.random.split(key, 48))
    f32 = jnp.float32
    D = D_MODEL
    ne, no = (DEPTH + 1) // 2, DEPTH // 2

    def nrm(shape, scale=1.0):
        return scale * jax.random.normal(next(ks), shape, f32)

    def uni(shape, lo, hi):
        return jax.random.uniform(next(ks), shape, f32, lo, hi)

    ramp = jnp.arange(RWKV_WIDTH, dtype=f32) / (RWKV_WIDTH - 1)
    return {
        "x": nrm((BATCH, SEQ, D)),
        "c": nrm((BATCH, D)),
        "ctx": nrm((BATCH, CTX_LEN, D)),
        "c_ctx": nrm((D,)),
        "norm_g": 1.0 + nrm((DEPTH, 3, D), 0.05),
        "mod_w": nrm((DEPTH, D, N_MOD * D), 0.5 * D ** -0.5),
        "mod_b": nrm((DEPTH, N_MOD * D), 0.02),
        "ffn_w1": nrm((DEPTH, 2, D, 2 * D_FF), D ** -0.5),
        "ffn_w2": nrm((DEPTH, 2, D_FF, D), D_FF ** -0.5),
        "ab_in_w": nrm((ne, D, AB_PROJ), D ** -0.5),
        "ab_out_w": nrm((ne, D, D), D ** -0.5),
        "rwkv_mu": uni((ne, 2, RWKV_PROJ), 0.05, 0.45),
        "rwkv_w0": (-5.5 + 5.0 * ramp ** 0.85) + nrm((ne, 2, RWKV_WIDTH), 0.1),
        "rwkv_w2": nrm((ne, 2, RWKV_DECAY_LORA, RWKV_WIDTH), 0.5 * RWKV_DECAY_LORA ** -0.5),
        "rwkv_a0": nrm((ne, 2, RWKV_WIDTH), 0.1),
        "rwkv_a2": nrm((ne, 2, RWKV_ICLR_LORA, RWKV_WIDTH), 0.5 * RWKV_ICLR_LORA ** -0.5),
        "rwkv_g2": nrm((ne, RWKV_GATE_LORA, RWKV_WIDTH), RWKV_GATE_LORA ** -0.5),
        "rwkv_k_k": 0.85 + nrm((ne, RWKV_WIDTH), 0.05),
        "rwkv_k_a": 1.0 + nrm((ne, RWKV_WIDTH), 0.05),
        "rwkv_r_k": nrm((ne, RWKV_HEADS, HEAD_DIM), 0.1),
        "rwkv_lnx_g": 1.0 + nrm((ne, RWKV_WIDTH), 0.05),
        "rwkv_lnx_b": nrm((ne, RWKV_WIDTH), 0.02),
        "s5_a_re": -0.5 + nrm((ne, 2, S5_GROUPS, S5_STATE), 0.01),
        "s5_a_im": math.pi * jnp.arange(S5_STATE, dtype=f32) + nrm((ne, 2, S5_GROUPS, S5_STATE), 0.01),
        "s5_log_step": uni((ne, 2, S5_GROUPS), math.log(1e-3), math.log(1e-1)),
        "s5_b_re": nrm((ne, 2, S5_GROUPS, S5_STATE, S5_GROUP_CH), (2 * S5_GROUP_CH) ** -0.5),
        "s5_b_im": nrm((ne, 2, S5_GROUPS, S5_STATE, S5_GROUP_CH), (2 * S5_GROUP_CH) ** -0.5),
        "s5_c_re": nrm((ne, 2, S5_GROUPS, S5_GROUP_CH, S5_STATE), S5_STATE ** -0.5),
        "s5_c_im": nrm((ne, 2, S5_GROUPS, S5_GROUP_CH, S5_STATE), S5_STATE ** -0.5),
        "s5_d": nrm((ne, S5_WIDTH), 0.5),
        "s5_glu_w": nrm((ne, S5_WIDTH, S5_WIDTH), S5_WIDTH ** -0.5),
        "s5_glu_b": nrm((ne, S5_WIDTH), 0.02),
        "attn_in_w": nrm((no, D, C_PROJ), D ** -0.5),
        "attn_out_w": nrm((no, D, D), D ** -0.5),
        "attn_sink": nrm((no, ATTN_HEADS), 0.5),
        "final_g": 1.0 + nrm((D,), 0.05),
    }


def reference(x, c, ctx, c_ctx, norm_g, mod_w, mod_b, ffn_w1, ffn_w2, ab_in_w, ab_out_w, rwkv_mu, rwkv_w0,
              rwkv_w2, rwkv_a0, rwkv_a2, rwkv_g2, rwkv_k_k, rwkv_k_a, rwkv_r_k, rwkv_lnx_g, rwkv_lnx_b,
              s5_a_re, s5_a_im, s5_log_step, s5_b_re, s5_b_im, s5_c_re, s5_c_im, s5_d, s5_glu_w, s5_glu_b,
              attn_in_w, attn_out_w, attn_sink, final_g):
    f32 = jnp.float32
    n_lat = x.shape[1]
    rows = n_lat // GRID_W
    row_id = jnp.repeat(jnp.arange(rows, dtype=f32), GRID_W)
    col_id = jnp.tile(jnp.arange(GRID_W, dtype=f32), rows)
    inv_freq = ROPE_BASE ** (-jnp.arange(0, ROPE_AXIS_DIM, 2, dtype=f32) / ROPE_AXIS_DIM)
    ang = jnp.concatenate([row_id[:, None] * inv_freq, col_id[:, None] * inv_freq], axis=-1)
    cos, sin = jnp.cos(ang), jnp.sin(ang)

    xc = ctx
    for l in range(DEPTH):
        last = l == DEPTH - 1
        ml = [m[:, None, :] for m in jnp.split(jax.nn.silu(c) @ mod_w[l] + mod_b[l], N_MOD, axis=-1)]
        mc = jnp.split(jax.nn.silu(c_ctx) @ mod_w[l] + mod_b[l], N_MOD, axis=-1)
        x = x + 0.5 * ml[2] * _swiglu(_modnorm(x, norm_g[l, 0], ml[0], ml[1]), ffn_w1[l, 0], ffn_w2[l, 0])
        xc = xc + 0.5 * mc[2] * _swiglu(_modnorm(xc, norm_g[l, 0], mc[0], mc[1]), ffn_w1[l, 0], ffn_w2[l, 0])
        hl = _modnorm(x, norm_g[l, 1], ml[3], ml[4])
        hc = _modnorm(xc, norm_g[l, 1], mc[3], mc[4])
        if l % 2 == 0:
            e = l // 2
            yl, yc = _mixer_ab(hl, hc, ab_in_w[e], ab_out_w[e], rwkv_mu[e], rwkv_w0[e], rwkv_w2[e], rwkv_a0[e],
                               rwkv_a2[e], rwkv_g2[e], rwkv_k_k[e], rwkv_k_a[e], rwkv_r_k[e], rwkv_lnx_g[e],
                               rwkv_lnx_b[e], s5_a_re[e], s5_a_im[e], s5_log_step[e], s5_b_re[e], s5_b_im[e],
                               s5_c_re[e], s5_c_im[e], s5_d[e], s5_glu_w[e], s5_glu_b[e])
        else:
            o = l // 2
            yl, yc = _mixer_c(hl, hc, attn_in_w[o], attn_out_w[o], attn_sink[o], cos, sin, not last)
        x = x + ml[5] * yl
        x = x + 0.5 * ml[8] * _swiglu(_modnorm(x, norm_g[l, 2], ml[6], ml[7]), ffn_w1[l, 1], ffn_w2[l, 1])
        if not last:
            xc = xc + mc[5] * yc
            xc = xc + 0.5 * mc[8] * _swiglu(_modnorm(xc, norm_g[l, 2], mc[6], mc[7]), ffn_w1[l, 1], ffn_w2[l, 1])
    return _rmsnorm(x, final_g)
```

```cpp
#include <hip/hip_runtime.h>
#include <stdint.h>
#include <cstdio>
#include <hip/amd_detail/amd_hip_unsafe_atomics.h>

#ifndef N_LAUNCH_MODE
#define N_LAUNCH_MODE 1
#endif

#ifndef REP_MASK
#define REP_MASK 0u
#endif
#define LAS __attribute__((address_space(3)))
typedef unsigned short bf16_t;
typedef short bf16x8 __attribute__((ext_vector_type(8)));
typedef short s16x4 __attribute__((ext_vector_type(4)));
typedef float f32x4 __attribute__((ext_vector_type(4)));
typedef float f32x2 __attribute__((ext_vector_type(2)));
typedef unsigned u32x4 __attribute__((ext_vector_type(4)));
typedef unsigned u32x2 __attribute__((ext_vector_type(2)));
typedef _Float16 h16;

constexpr int NB = 4, SEQ = 4096, LC = 256, LT = 4352, MR = 17408, DM = 1024, DFF = 2816;
constexpr int NCH = 136;
constexpr int NROWS_G = 544;
constexpr size_t SZ512 = (size_t)MR * 512 * 2;
constexpr size_t OFF_BAR = 0;
constexpr size_t OFF_LORA = 16384;
constexpr size_t OFF_ROWSQ = OFF_LORA + 1310720;
constexpr size_t OFF_XC = OFF_ROWSQ + 487424;
constexpr size_t OFF_MODS = OFF_XC + 4194304;
constexpr size_t OFF_ROPE = OFF_MODS + 368640;
constexpr size_t OFF_KTAB = OFF_ROPE + 1048576;
constexpr size_t SZ_W1T = 11534336, SZ_W2T = 5767168;
constexpr size_t OFF_W1T0 = OFF_KTAB + 2097152;
constexpr size_t OFF_W2T0 = OFF_W1T0 + 2 * SZ_W1T;
constexpr size_t OFF_ABIN = OFF_W2T0 + 2 * SZ_W2T;
constexpr size_t OFF_ABOUT = OFF_ABIN + 4718592;
constexpr size_t OFF_GLU = OFF_ABOUT + 2097152;
constexpr size_t OFF_KG = OFF_GLU + 524288;
constexpr size_t OFF_F = OFF_KG + 25165824;
constexpr size_t OFF_A = OFF_F + 8388608;
constexpr size_t OFF_ACT = OFF_A + 35651584;
constexpr size_t OFF_P = OFF_ACT;
constexpr size_t OFF_G = OFF_ACT + 80216064;
constexpr size_t OFF_Q = OFF_ACT;
constexpr size_t OFF_K = OFF_ACT + 35651584;
constexpr size_t OFF_V = OFF_K + 8912896;
constexpr size_t OFF_LW = OFF_ACT + 98041856;
constexpr size_t OFF_MIX = OFF_LW;
constexpr size_t OFF_LWA = OFF_P;
constexpr size_t OFF_CAT = OFF_P;
constexpr size_t OFF_W1T1 = OFF_LW;
constexpr size_t OFF_W2T1 = OFF_W1T1 + 2 * SZ_W1T;
constexpr size_t OFF_ATTNIN = OFF_W2T1 + 2 * SZ_W2T;
constexpr size_t OFF_ATTNOUT = OFF_ATTNIN + 3145728;
constexpr size_t OFF_ALORA = OFF_LW + 71303168;
constexpr size_t OFF_UX = OFF_ALORA + 8912896;
constexpr size_t OFF_E = OFF_UX + 26738688;
constexpr size_t OFF_GAM = OFF_E + 17825792;
constexpr size_t OFF_BETA = OFF_GAM + 143360;
constexpr size_t WS_NEED = OFF_BETA + 788480;
constexpr size_t OFF_O = OFF_ALORA;
constexpr int LDS_BYTES = 163840;
constexpr int MISC_OFF = 163840 - 256;

struct Params { const float* in[36]; float* out; unsigned char* ws; int ph_lo, ph_hi; };
#define PIN(i) (((const float* const volatile __attribute__((address_space(4)))*)__builtin_amdgcn_kernarg_segment_ptr())[(i)])

__device__ __forceinline__ bf16_t f2bf(float f) { unsigned u = __float_as_uint(f); u += 0x7fffu + ((u >> 16) & 1u); return (bf16_t)(u >> 16); }
__device__ __forceinline__ float bf2f(unsigned h) { return __uint_as_float(h << 16); }
__device__ __forceinline__ unsigned cvt_pk_bf16(float lo, float hi) { unsigned r; asm volatile("v_cvt_pk_bf16_f32 %0, %1, %2" : "=v"(r) : "v"(lo), "v"(hi)); return r; }
__device__ __forceinline__ unsigned pk_h16(float lo, float hi) { h16 a = (h16)lo, b = (h16)hi; return (unsigned)__builtin_bit_cast(unsigned short, a) | ((unsigned)__builtin_bit_cast(unsigned short, b) << 16); }
__device__ __forceinline__ float h2f(unsigned h) { return (float)__builtin_bit_cast(h16, (unsigned short)h); }
__device__ __forceinline__ float lo_bf(unsigned w) { return __uint_as_float(w << 16); }
__device__ __forceinline__ float hi_bf(unsigned w) { return __uint_as_float(w & 0xffff0000u); }
__device__ __forceinline__ float lo_h(unsigned w) { return h2f(w & 0xffffu); }
__device__ __forceinline__ float hi_h(unsigned w) { return h2f(w >> 16); }
__device__ __forceinline__ float sigmoidf_(float x) { return __builtin_amdgcn_rcpf(1.0f + __expf(-x)); }
__device__ __forceinline__ float siluf_(float x) { return x * sigmoidf_(x); }
__device__ __forceinline__ float wave_sum(float v) { for (int o = 32; o >= 1; o >>= 1) v += __shfl_xor(v, o); return v; }
template <int CTRL> __device__ __forceinline__ float dpp_mov(float x) { return __builtin_bit_cast(float, __builtin_amdgcn_update_dpp(0, __builtin_bit_cast(int, x), CTRL, 0xf, 0xf, false)); }
__device__ __forceinline__ float allreduce16(float x) { x += dpp_mov<0x128>(x); x += dpp_mov<0x124>(x); x += dpp_mov<0x122>(x); x += dpp_mov<0x121>(x); return x; }

__device__ __forceinline__ float fma_s(float a, float b, float c) { float d; asm("v_fma_f32 %0, %1, %2, %3" : "=v"(d) : "v"(a), "v"(b), "v"(c)); return d; }
__device__ __forceinline__ float fnma_s(float a, float b, float c) { float d; asm("v_fma_f32 %0, -%1, %2, %3" : "=v"(d) : "v"(a), "v"(b), "v"(c)); return d; }
__device__ __forceinline__ float mul_s(float a, float b) { float d; asm("v_mul_f32 %0, %1, %2" : "=v"(d) : "v"(a), "v"(b)); return d; }
__device__ __forceinline__ float mixlo(unsigned h, float x, float c) { float d; asm("v_fma_mix_f32 %0, %1, %2, %3 op_sel:[0,0,0] op_sel_hi:[1,0,0]" : "=v"(d) : "v"(h), "v"(x), "v"(c)); return d; }
__device__ __forceinline__ float mixhi(unsigned h, float x, float c) { float d; asm("v_fma_mix_f32 %0, %1, %2, %3 op_sel:[1,0,0] op_sel_hi:[1,0,0]" : "=v"(d) : "v"(h), "v"(x), "v"(c)); return d; }
#define LDS_BARRIER() do { asm volatile("s_waitcnt lgkmcnt(0)" ::: "memory"); __builtin_amdgcn_s_barrier(); asm volatile("" ::: "memory"); } while (0)
__device__ __forceinline__ int otid() { int t = threadIdx.x; asm volatile("" : "+v"(t)); return t; }
__device__ __forceinline__ const float* in_row(const Params& p, int b, int t) { return t < LC ? PIN(2) + ((size_t)b * LC + t) * DM : PIN(0) + ((size_t)b * SEQ + (t - LC)) * DM; }
__device__ __forceinline__ float* x_row(const Params& p, int b, int t) { return t < LC ? (float*)(p.ws + OFF_XC) + ((size_t)b * LC + t) * DM : p.out + ((size_t)b * SEQ + (t - LC)) * DM; }

#define XB_TMO      128
#define XB_XCNT(j)  (256  + 64 * (j))
#define XB_XSUB(j)  (1280 + 64 * (j))
#define XB_XGEN(j)  (2304 + 64 * (j))
#define XB_TOP      3328
#define XB_TOPGEN   3392
#define XCD_BAR_WORDS 3456
#define XB_SPIN_CAP (1u << 20)
__device__ __forceinline__ unsigned xb_ld(unsigned* p)              { return __hip_atomic_load(p, __ATOMIC_RELAXED, __HIP_MEMORY_SCOPE_AGENT); }
__device__ __forceinline__ unsigned xb_add(unsigned* p, unsigned v) { return __hip_atomic_fetch_add(p, v, __ATOMIC_RELAXED, __HIP_MEMORY_SCOPE_AGENT); }
__device__ __forceinline__ unsigned xb_xcc_id() { return (unsigned)__builtin_amdgcn_s_getreg((3 << 11) | 20) & 0xFu; }
#define XB_SPIN(cond, bar) do { unsigned _sp = 0; while (cond) { __builtin_amdgcn_s_sleep(1); \
    if ((++_sp & 255u) == 0u) { if (xb_ld(&(bar)[XB_TMO])) break; if (_sp > XB_SPIN_CAP) { atomicAdd(&(bar)[XB_TMO], 1u); break; } } } } while (0)
struct XcdBarrier { unsigned* bar; unsigned x; volatile LAS unsigned* st; };
__device__ __forceinline__ XcdBarrier xcd_barrier_post(unsigned* bar, volatile LAS unsigned* st) {
    XcdBarrier b; b.bar = bar; b.x = xb_xcc_id(); b.st = st;
    if (threadIdx.x == 0) (void)xb_add(&bar[XB_XCNT(b.x)], 1u);
    return b;
}
__device__ __forceinline__ void xcd_barrier_complete(unsigned* bar, unsigned x, unsigned& nloc, unsigned& nx) {
    const unsigned G = gridDim.x * gridDim.y * gridDim.z;
    unsigned sum, cnt, mine, sp = 0u;
    for (;;) {
        sum = 0u; cnt = 0u; mine = 0u;
#pragma unroll
        for (unsigned j = 0; j < 16; ++j) { const unsigned c = xb_ld(&bar[XB_XCNT(j)]); sum += c; cnt += (c > 0u) ? 1u : 0u; mine = (j == x) ? c : mine; }
        if (sum == G) break;
        __builtin_amdgcn_s_sleep(1);
        if ((++sp & 255u) == 0u) { if (xb_ld(&bar[XB_TMO])) break; if (sp > XB_SPIN_CAP) { atomicAdd(&bar[XB_TMO], 1u); break; } }
    }
    nloc = mine > 0u ? mine : 1u; nx = cnt > 0u ? cnt : 1u;
}
__device__ __forceinline__ void xcd_barrier(const XcdBarrier& b) {
    asm volatile("s_waitcnt vmcnt(0)" ::: "memory");
    __syncthreads();
    if (threadIdx.x == 0) {
        unsigned* bar = b.bar;
        __builtin_amdgcn_s_waitcnt(0);
        unsigned nloc = b.st[0], nx = b.st[1];
        if (nloc == 0u) { xcd_barrier_complete(bar, b.x, nloc, nx); b.st[0] = nloc; b.st[1] = nx; }
        const unsigned old = xb_add(&bar[XB_XSUB(b.x)], 1u);
        const unsigned gen = old / nloc;
        if (old + 1u == (gen + 1u) * nloc) {
            __builtin_amdgcn_fence(__ATOMIC_RELEASE, "agent");
            asm volatile("s_waitcnt vmcnt(0)" ::: "memory");
            const unsigned og = xb_add(&bar[XB_TOP], 1u);
            const unsigned tg = og / nx;
            if (og + 1u == (tg + 1u) * nx) xb_add(&bar[XB_TOPGEN], 1u);
            else XB_SPIN(xb_ld(&bar[XB_TOPGEN]) == tg, bar);
            __builtin_amdgcn_fence(__ATOMIC_ACQUIRE, "agent");
            xb_add(&bar[XB_XGEN(b.x)], 1u);
            asm volatile("s_waitcnt vmcnt(0)" ::: "memory");
        } else {
            XB_SPIN(xb_ld(&bar[XB_XGEN(b.x)]) == gen, bar);
            __builtin_amdgcn_fence(__ATOMIC_ACQUIRE, "agent");
            asm volatile("s_waitcnt vmcnt(0)" ::: "memory");
        }
    }
    __syncthreads();
}

namespace pg8 {
constexpr int BM = 256, BK = 64, HALF = 128, HTB = HALF * BK * 2, STAGE_BYTES = 8 * HTB, NXCD = 8, WGM = 8;
__device__ __forceinline__ int lds_byte(int r, int c) { const int st = (r >> 4) * 2 + (c >> 5), rr = r & 15, cc = c & 31, ob = rr * 64 + cc * 2; return st * 1024 + (ob ^ (((ob >> 9) & 1) << 5)); }
__device__ __forceinline__ void stage_rc(int b, int& R, int& C) { const int st = b / 1024, sb = b % 1024, swz = sb ^ (((sb >> 9) & 1) << 5); R = (st >> 1) * 16 + swz / 64; C = (st & 1) * 32 + (swz % 64) / 2; }
__device__ __forceinline__ int perm32(int rho) { const int n = rho >> 4, i = rho & 15; return 8 * (i >> 2) + 4 * n + (i & 3); }
struct Unit { int arow, brow, pm, pn, g; };
struct Gemm { const bf16_t* A; const bf16_t* Bt; int K, lda, ldb; };
struct Sched {
    int nM, nN, nwg, G, c, mode, browg;
    __device__ void init(int mode_, int nM_, int nN_, int ng, int browg_, int G_, int c_) { mode = mode_; nM = nM_; nN = nN_; nwg = nM_ * nN_ * ng; browg = browg_; G = G_; c = c_; }
    __device__ bool next(int i, Unit& u) const {
        const long L = (long)i * G + c; if (L >= nwg) return false;
        int wgid = (int)L;
        if (mode <= 1) {
            { const int q = nwg / NXCD, r = nwg % NXCD, xcd = wgid % NXCD, off = wgid / NXCD; wgid = (xcd < r ? xcd * (q + 1) : r * (q + 1) + (xcd - r) * q) + off; }
            const int nig = WGM * nN, gid = wgid / nig, fm = gid * WGM, gsz = (nM - fm) < WGM ? (nM - fm) : WGM;
            int pm = fm + ((wgid % nig) % gsz); const int pn = (wgid % nig) / gsz;
            if (mode == 1) pm = (pm >> 4) * 17 + 1 + (pm & 15);
            u.pm = pm; u.pn = pn; u.g = 0; u.arow = pm * BM; u.brow = pn * BM;
        } else {
            const int per = nM * nN, g = wgid / per, rem = wgid % per;
            u.g = g; u.pm = rem % nM; u.pn = rem / nM; u.arow = g * NROWS_G + u.pm * BM; u.brow = g * browg + u.pn * BM;
        }
        return true;
    }
};

template <class Epi>
__device__ __forceinline__ void gemm_phase(LAS unsigned char* lds, const Gemm g, const Sched& S, const Epi& E) {
    const int tid = otid(), wid = __builtin_amdgcn_readfirstlane(tid >> 6), lane = tid & 63, wr = wid >> 2, wc = wid & 3, fr = lane & 15, fq = lane >> 4;
    const int K = g.K, nt = K / BK;
    unsigned voffA[2], voffB[2];
#pragma unroll
    for (int i = 0; i < 2; ++i) { int R, C; stage_rc(tid * 16 + i * 8192, R, C); const int Rb = Epi::PERM ? ((R & ~31) + perm32(R & 31)) : R;
        voffA[i] = (unsigned)(R * g.lda + C) * 2u; voffB[i] = (unsigned)(Rb * g.ldb + C) * 2u; }
    const size_t kstep = (size_t)(BK * 2);
    const size_t hstepA = (size_t)HALF * g.lda * 2, hstepB = (size_t)HALF * g.ldb * 2;
    const unsigned ldsw = (unsigned)wid * 1024u;
    const int aoff = lds_byte(wr * 64 + fr, fq * 8), boff = lds_byte(wc * 32 + fr, fq * 8);
#define PG8_SA(b, h) (((b) * 2 + (h)) * HTB)
#define PG8_SB(b, h) ((4 + (b) * 2 + (h)) * HTB)
#define PG8_STAGE(bufoff, gbase, voff) do { _Pragma("unroll") for (int _i = 0; _i < 2; ++_i) \
        __builtin_amdgcn_global_load_lds((const unsigned*)((const char*)(gbase) + (voff)[_i]), (LAS unsigned*)(lds + (bufoff) + ldsw + _i * 8192), 16, 0, 0); } while (0)
#define PG8_LDA(dst, b, h) do { _Pragma("unroll") for (int m = 0; m < 4; ++m) _Pragma("unroll") for (int k = 0; k < 2; ++k) dst[m][k] = *(const LAS bf16x8*)(lds + PG8_SA(b, h) + aoff + m * 2048 + k * 1024); } while (0)
#define PG8_LDB(dst, b, h) do { _Pragma("unroll") for (int n = 0; n < 2; ++n) _Pragma("unroll") for (int k = 0; k < 2; ++k) dst[n][k] = *(const LAS bf16x8*)(lds + PG8_SB(b, h) + boff + n * 2048 + k * 1024); } while (0)
#define PG8_MMA(ai, bj, At, Bt) do { __builtin_amdgcn_s_setprio(1); _Pragma("unroll") for (int m = 0; m < 4; ++m) _Pragma("unroll") for (int n = 0; n < 2; ++n) _Pragma("unroll") for (int k = 0; k < 2; ++k) \
        acc[ai][bj][m][n] = __builtin_amdgcn_mfma_f32_16x16x32_bf16(Bt[n][k], At[m][k], acc[ai][bj][m][n], 0, 0, 0); __builtin_amdgcn_s_setprio(0); } while (0)
#define PG8_WAIT_V(n) asm volatile("s_waitcnt vmcnt(" #n ")" ::: "memory")
#define PG8_WAIT_L(n) asm volatile("s_waitcnt lgkmcnt(" #n ")" ::: "memory")
#define PG8_BAR __builtin_amdgcn_s_barrier()
#define PG8_SCHED __builtin_amdgcn_sched_barrier(0)
    Unit cur, nxt; int ui = 0;
    if (!S.next(0, cur)) return;
    f32x4 acc[2][2][4][2];
#pragma unroll
    for (int a = 0; a < 2; ++a)
#pragma unroll
        for (int b = 0; b < 2; ++b)
#pragma unroll
            for (int m = 0; m < 4; ++m)
#pragma unroll
                for (int n = 0; n < 2; ++n) acc[a][b][m][n] = (f32x4){0.f, 0.f, 0.f, 0.f};
    bf16x8 At[4][2], B0[2][2], B1[2][2];
    const char* cA = (const char*)g.A + (size_t)cur.arow * g.lda * 2; const char* cB = (const char*)g.Bt + (size_t)cur.brow * g.ldb * 2;
    PG8_STAGE(PG8_SB(0, 0), cB, voffB); PG8_STAGE(PG8_SA(0, 0), cA, voffA); PG8_STAGE(PG8_SB(0, 1), cB + hstepB, voffB); PG8_STAGE(PG8_SA(0, 1), cA + hstepA, voffA);
    if (wr == 1) PG8_BAR;
    PG8_WAIT_V(4); PG8_BAR;
    PG8_STAGE(PG8_SB(1, 0), cB + kstep, voffB); PG8_STAGE(PG8_SA(1, 0), cA + kstep, voffA); PG8_STAGE(PG8_SB(1, 1), cB + hstepB + kstep, voffB);
    PG8_WAIT_V(6); PG8_BAR;
    for (;;) {
        const bool has_next = S.next(ui + 1, nxt);
        const char* nA = has_next ? (const char*)g.A + (size_t)nxt.arow * g.lda * 2 : cA; const char* nB = has_next ? (const char*)g.Bt + (size_t)nxt.brow * g.ldb * 2 : cB;
        for (int t = 0; t < nt; t += 2) {
            const bool last = (t == nt - 2);
            const char* a1 = cA + (size_t)(t + 1) * kstep;
            const char* a2 = last ? nA : cA + (size_t)(t + 2) * kstep; const char* b2 = last ? nB : cB + (size_t)(t + 2) * kstep;
            const char* a3 = a2 + kstep; const char* b3 = b2 + kstep;
            PG8_LDB(B0, 0, 0); PG8_SCHED; PG8_LDA(At, 0, 0); PG8_STAGE(PG8_SA(1, 1), a1 + hstepA, voffA);
            PG8_WAIT_L(8); PG8_BAR; PG8_WAIT_L(0); PG8_MMA(0, 0, At, B0); PG8_BAR; PG8_SCHED;
            PG8_LDB(B1, 0, 1); PG8_STAGE(PG8_SB(0, 0), b2, voffB);
            PG8_BAR; PG8_WAIT_L(0); PG8_MMA(0, 1, At, B1); PG8_BAR;
            PG8_LDA(At, 0, 1); PG8_STAGE(PG8_SA(0, 0), a2, voffA);
            PG8_BAR; PG8_WAIT_L(0); PG8_MMA(1, 0, At, B0); PG8_BAR; PG8_SCHED;
            PG8_STAGE(PG8_SB(0, 1), b2 + hstepB, voffB);
            PG8_WAIT_V(6); PG8_BAR; PG8_MMA(1, 1, At, B1); PG8_BAR;
            PG8_LDB(B0, 1, 0); PG8_SCHED; PG8_LDA(At, 1, 0); PG8_STAGE(PG8_SA(0, 1), a2 + hstepA, voffA);
            PG8_WAIT_L(8); PG8_BAR; PG8_WAIT_L(0); PG8_MMA(0, 0, At, B0); PG8_BAR; PG8_SCHED;
            PG8_LDB(B1, 1, 1); PG8_STAGE(PG8_SB(1, 0), b3, voffB);
            PG8_BAR; PG8_WAIT_L(0); PG8_MMA(0, 1, At, B1); PG8_BAR;
            PG8_LDA(At, 1, 1); PG8_STAGE(PG8_SA(1, 0), a3, voffA);
            PG8_BAR; PG8_WAIT_L(0); PG8_MMA(1, 0, At, B0); PG8_BAR; PG8_SCHED;
            PG8_STAGE(PG8_SB(1, 1), b3 + hstepB, voffB);
            PG8_WAIT_V(6); PG8_BAR; PG8_MMA(1, 1, At, B1); PG8_BAR;
        }
        E(acc, cur, wr, wc, fr, fq);
        if (!has_next) break;
#pragma unroll
        for (int a = 0; a < 2; ++a)
#pragma unroll
            for (int b = 0; b < 2; ++b)
#pragma unroll
                for (int m = 0; m < 4; ++m)
#pragma unroll
                    for (int n = 0; n < 2; ++n) acc[a][b][m][n] = (f32x4){0.f, 0.f, 0.f, 0.f};
        cur = nxt; cA = nA; cB = nB; ++ui;
    }
    PG8_WAIT_V(0);
    if (wr == 0) PG8_BAR;
    PG8_BAR;
#undef PG8_SA
#undef PG8_SB
#undef PG8_STAGE
#undef PG8_LDA
#undef PG8_LDB
#undef PG8_MMA
#undef PG8_WAIT_V
#undef PG8_WAIT_L
#undef PG8_BAR
#undef PG8_SCHED
}

typedef f32x4 AccT[2][2][4][2];

struct EpiSwiglu {
    static constexpr bool PERM = true; bf16_t* O; const float* rowsq; const float* beta;
    __device__ __forceinline__ void operator()(const AccT& acc, const Unit& u, int wr, int wc, int fr, int fq) const {
        const int b = u.pm / 17, pt = u.pm % 17;
        const float* bt = beta + (size_t)(pt == 0 ? 4 : b) * 5632 + u.pn * BM + wc * 32 + 8 * fq;
        const f32x4 bg0 = *(const f32x4*)bt, bg1 = *(const f32x4*)(bt + 4), bu0 = *(const f32x4*)(bt + HALF), bu1 = *(const f32x4*)(bt + HALF + 4);
        float rsv[2][4];
#pragma unroll
        for (int ai = 0; ai < 2; ++ai)
#pragma unroll
            for (int m = 0; m < 4; ++m) rsv[ai][m] = rowsq[(size_t)u.pm * BM + ai * HALF + wr * 64 + m * 16 + fr];
#pragma unroll
        for (int ai = 0; ai < 2; ++ai)
#pragma unroll
            for (int m = 0; m < 4; ++m) {
                const size_t row = (size_t)u.pm * BM + ai * HALF + wr * 64 + m * 16 + fr;
                const float rs = rsqrtf(rsv[ai][m] * (1.0f / 1024.0f) + 1e-6f);
                const f32x4 g0 = acc[ai][0][m][0] * rs + bg0, g1 = acc[ai][0][m][1] * rs + bg1, u0 = acc[ai][1][m][0] * rs + bu0, u1 = acc[ai][1][m][1] * rs + bu1;
                u32x4 w; w.x = cvt_pk_bf16(siluf_(g0[0]) * u0[0], siluf_(g0[1]) * u0[1]); w.y = cvt_pk_bf16(siluf_(g0[2]) * u0[2], siluf_(g0[3]) * u0[3]);
                w.z = cvt_pk_bf16(siluf_(g1[0]) * u1[0], siluf_(g1[1]) * u1[1]); w.w = cvt_pk_bf16(siluf_(g1[2]) * u1[2], siluf_(g1[3]) * u1[3]);
                *(u32x4*)(O + row * DFF + u.pn * 128 + wc * 32 + 8 * fq) = w;
            }
    }
};
template <bool HALFG, bool FUSE> struct EpiResid {
    static constexpr bool PERM = false;
    const float* src_lat; const float* src_ctx; float* dst_lat; float* dst_ctx; const float* mods_l; int gate_chunk;
    bf16_t* An; const float* gam; float* rowsq;
    __device__ __forceinline__ void operator()(const AccT& acc, const Unit& u, int wr, int wc, int fr, int fq) const {
        const int b = u.pm / 17, pt = u.pm % 17, mv = pt == 0 ? 4 : b;
        const float* gate = mods_l + (size_t)mv * 9216 + gate_chunk * 1024;
        const int col0 = u.pn * BM + wc * 32 + 4 * fq;
        f32x4 gv[2][2];
#pragma unroll
        for (int bj = 0; bj < 2; ++bj)
#pragma unroll
            for (int n = 0; n < 2; ++n) gv[bj][n] = *(const f32x4*)(gate + col0 + bj * HALF + n * 16) * (HALFG ? 0.5f : 1.0f);
        const float* gm = gam + (size_t)mv * 1024 + col0;
        f32x4 gmv[2][2];
#pragma unroll
        for (int bj = 0; bj < 2; ++bj)
#pragma unroll
            for (int n = 0; n < 2; ++n) gmv[bj][n] = FUSE ? *(const f32x4*)(gm + bj * HALF + n * 16) : (f32x4){0.f, 0.f, 0.f, 0.f};
        const float* sbase = (pt == 0 ? src_ctx : src_lat) + ((pt == 0) ? ((size_t)b * LC) * DM : ((size_t)b * SEQ + (pt - 1) * 256) * DM) + col0;
        float* dbase = (pt == 0 ? dst_ctx : dst_lat) + ((pt == 0) ? ((size_t)b * LC) * DM : ((size_t)b * SEQ + (pt - 1) * 256) * DM) + col0;
        f32x4 sv[2][2];
        { const float* sp = sbase + (size_t)(wr * 64 + fr) * DM;
#pragma unroll
          for (int bj = 0; bj < 2; ++bj)
#pragma unroll
              for (int n = 0; n < 2; ++n) sv[bj][n] = *(const f32x4*)(sp + bj * HALF + n * 16); }
#pragma unroll
        for (int idx = 0; idx < 8; ++idx) {
            const int ai = idx >> 2, m = idx & 3;
            const int rl = ai * HALF + wr * 64 + m * 16 + fr;
            f32x4 nx[2][2];
            if (idx + 1 < 8) { const int rl2 = ((idx + 1) >> 2) * HALF + wr * 64 + ((idx + 1) & 3) * 16 + fr; const float* sp = sbase + (size_t)rl2 * DM;
#pragma unroll
                for (int bj = 0; bj < 2; ++bj)
#pragma unroll
                    for (int n = 0; n < 2; ++n) nx[bj][n] = *(const f32x4*)(sp + bj * HALF + n * 16); }
            float* dp = dbase + (size_t)rl * DM;
            const size_t row = (size_t)u.pm * BM + rl;
            float ss = 0.f;
#pragma unroll
            for (int bj = 0; bj < 2; ++bj)
#pragma unroll
                for (int n = 0; n < 2; ++n) { const f32x4 xn = sv[bj][n] + gv[bj][n] * acc[ai][bj][m][n]; *(f32x4*)(dp + bj * HALF + n * 16) = xn;
                    if (FUSE) { ss += xn[0] * xn[0] + xn[1] * xn[1] + xn[2] * xn[2] + xn[3] * xn[3];
                        const f32x4 a = xn * gmv[bj][n]; u32x2 w; w.x = cvt_pk_bf16(a[0], a[1]); w.y = cvt_pk_bf16(a[2], a[3]);
                        *(u32x2*)(An + row * DM + col0 + bj * HALF + n * 16) = w; } }
            if (FUSE) { ss += __shfl_xor(ss, 16); ss += __shfl_xor(ss, 32); if (fq == 0) unsafeAtomicAdd(rowsq + row, ss); }
            if (idx + 1 < 8) {
#pragma unroll
                for (int bj = 0; bj < 2; ++bj)
#pragma unroll
                    for (int n = 0; n < 2; ++n) sv[bj][n] = nx[bj][n]; }
        }
    }
};
struct EpiStoreBf16 {
    static constexpr bool PERM = true; bf16_t* O; int ldc; const float* rowsq; const float* beta; int nbeta;
    __device__ __forceinline__ void operator()(const AccT& acc, const Unit& u, int wr, int wc, int fr, int fq) const {
        const int b = u.pm / 17, pt = u.pm % 17;
        const float* bt = beta + (size_t)(pt == 0 ? 4 : b) * nbeta + u.pn * BM + wc * 32 + 8 * fq;
        float rsv[2][4];
#pragma unroll
        for (int ai = 0; ai < 2; ++ai)
#pragma unroll
            for (int m = 0; m < 4; ++m) rsv[ai][m] = rsqrtf(rowsq[(size_t)u.pm * BM + ai * HALF + wr * 64 + m * 16 + fr] * (1.0f / 1024.0f) + 1e-6f);
#pragma unroll
        for (int bj = 0; bj < 2; ++bj) {
            const f32x4 b0 = *(const f32x4*)(bt + bj * HALF), b1 = *(const f32x4*)(bt + bj * HALF + 4);
#pragma unroll
            for (int ai = 0; ai < 2; ++ai)
#pragma unroll
                for (int m = 0; m < 4; ++m) {
                    const size_t row = (size_t)u.pm * BM + ai * HALF + wr * 64 + m * 16 + fr;
                    const float rs = rsv[ai][m];
                    const f32x4 v0 = acc[ai][bj][m][0] * rs + b0, v1 = acc[ai][bj][m][1] * rs + b1;
                    u32x4 w; w.x = cvt_pk_bf16(v0[0], v0[1]); w.y = cvt_pk_bf16(v0[2], v0[3]); w.z = cvt_pk_bf16(v1[0], v1[1]); w.w = cvt_pk_bf16(v1[2], v1[3]);
                    *(u32x4*)(O + row * ldc + u.pn * BM + bj * HALF + wc * 32 + 8 * fq) = w; }
        }
    }
};
struct EpiLora {
    static constexpr bool PERM = true; unsigned char* ws; const float* w0; const float* a0;
    __device__ __forceinline__ void operator()(const AccT& acc, const Unit& u, int wr, int wc, int fr, int fq) const {
        const int grp = u.pn >> 1;
        unsigned short* O = (unsigned short*)(grp < 4 ? ws + OFF_LWA + (size_t)grp * SZ512 : ws + OFF_G);
        const float* bias = grp < 2 ? w0 + grp * 512 : (grp < 4 ? a0 + (grp - 2) * 512 : nullptr);
#pragma unroll
        for (int bj = 0; bj < 2; ++bj)
#pragma unroll
            for (int n = 0; n < 2; ++n) {
                const int cc = (u.pn & 1) * 256 + bj * HALF + wc * 32 + 8 * fq + 4 * n;
                f32x4 bv = {0.f, 0.f, 0.f, 0.f}; if (bias) bv = *(const f32x4*)(bias + cc);
#pragma unroll
                for (int ai = 0; ai < 2; ++ai)
#pragma unroll
                    for (int m = 0; m < 4; ++m) {
                        const size_t row = (size_t)u.pm * BM + ai * HALF + wr * 64 + m * 16 + fr;
                        const f32x4 z4 = acc[ai][bj][m][n] + bv; float v[4];
#pragma unroll
                        for (int e = 0; e < 4; ++e) { const float z = z4[e];
                            if (grp < 2) v[e] = -0.60653066f * sigmoidf_(z);
                            else if (grp < 4) v[e] = sigmoidf_(z);
                            else v[e] = z; }
                        u32x2 w; w.x = pk_h16(v[0], v[1]); w.y = pk_h16(v[2], v[3]);
                        *(u32x2*)(O + row * 512 + cc) = w;
                    }
            }
    }
};
struct EpiE {
    static constexpr bool PERM = false; float* E;
    __device__ __forceinline__ void operator()(const AccT& acc, const Unit& u, int wr, int wc, int fr, int fq) const {
#pragma unroll
        for (int ai = 0; ai < 2; ++ai)
#pragma unroll
            for (int m = 0; m < 4; ++m) {
                const int n = u.pm * BM + ai * HALF + wr * 64 + m * 16 + fr;
                if (n < NROWS_G) { float* rp = E + ((size_t)u.g * NROWS_G + n) * 256 + wc * 32 + 4 * fq;
#pragma unroll
                    for (int bj = 0; bj < 2; ++bj)
#pragma unroll
                        for (int nn = 0; nn < 2; ++nn) *(f32x4*)(rp + bj * HALF + nn * 16) = acc[ai][bj][m][nn]; }
            }
    }
};
__device__ __forceinline__ float gelu_tanh(float y) { const float t = 0.7978845608f * (y + 0.044715f * y * y * y); const float e = __expf(2.0f * t); const float th = 1.0f - 2.0f * __builtin_amdgcn_rcpf(e + 1.0f); return 0.5f * y * (1.0f + th); }
struct EpiY {
    static constexpr bool PERM = false; const bf16_t* UX; const float* dsk; bf16_t* Z;
    __device__ __forceinline__ void operator()(const AccT& acc, const Unit& u, int wr, int wc, int fr, int fq) const {
        const int ch = u.g * 16 + 4 * fq;
        const f32x4 dv = *(const f32x4*)(dsk + ch);
#pragma unroll
        for (int ai = 0; ai < 2; ++ai)
#pragma unroll
            for (int m = 0; m < 4; ++m) {
                const int n = u.pm * BM + ai * HALF + wr * 64 + m * 16 + fr;
                if (n < NROWS_G) { const int b = n / NCH, c = n % NCH;
#pragma unroll
                    for (int bj = 0; bj < 2; ++bj)
#pragma unroll
                        for (int nn = 0; nn < 2; ++nn) {
                            const int mm = u.pn * BM + bj * HALF + wc * 32 + nn * 16 + 4 * fq;
                            const u32x2 uw = *(const u32x2*)(UX + ((size_t)u.g * NROWS_G + n) * 768 + mm);
                            const f32x4 a = acc[ai][bj][m][nn];
                            const float y0 = a[0] + dv[0] * lo_bf(uw.x), y1 = a[1] + dv[1] * hi_bf(uw.x), y2 = a[2] + dv[2] * lo_bf(uw.y), y3 = a[3] + dv[3] * hi_bf(uw.y);
                            u32x2 w; w.x = cvt_pk_bf16(gelu_tanh(y0), gelu_tanh(y1)); w.y = cvt_pk_bf16(gelu_tanh(y2), gelu_tanh(y3));
                            const size_t tok = (size_t)b * LT + c * 32 + (mm >> 4);
                            *(u32x2*)(Z + tok * 512 + ch) = w;
                        } }
            }
    }
};
struct EpiGlu {
    static constexpr bool PERM = true; const bf16_t* Z; const float* gb; bf16_t* CAT;
    __device__ __forceinline__ void operator()(const AccT& acc, const Unit& u, int wr, int wc, int fr, int fq) const {
#pragma unroll
        for (int bj = 0; bj < 2; ++bj) {
            const int cc = u.pn * BM + bj * HALF + wc * 32 + 8 * fq;
            const f32x4 b0 = *(const f32x4*)(gb + cc), b1 = *(const f32x4*)(gb + cc + 4);
#pragma unroll
            for (int ai = 0; ai < 2; ++ai)
#pragma unroll
                for (int m = 0; m < 4; ++m) {
                    const size_t row = (size_t)u.pm * BM + ai * HALF + wr * 64 + m * 16 + fr;
                    const u32x4 zw = *(const u32x4*)(Z + row * 512 + cc);
                    const f32x4 v0 = acc[ai][bj][m][0] + b0, v1 = acc[ai][bj][m][1] + b1;
                    u32x4 w; w.x = cvt_pk_bf16(lo_bf(zw.x) * sigmoidf_(v0[0]), hi_bf(zw.x) * sigmoidf_(v0[1])); w.y = cvt_pk_bf16(lo_bf(zw.y) * sigmoidf_(v0[2]), hi_bf(zw.y) * sigmoidf_(v0[3]));
                    w.z = cvt_pk_bf16(lo_bf(zw.z) * sigmoidf_(v1[0]), hi_bf(zw.z) * sigmoidf_(v1[1])); w.w = cvt_pk_bf16(lo_bf(zw.w) * sigmoidf_(v1[2]), hi_bf(zw.w) * sigmoidf_(v1[3]));
                    *(u32x4*)(CAT + row * DM + 512 + cc) = w;
                }
        }
    }
};
struct EpiQKV {
    static constexpr bool PERM = true; bf16_t* Q; bf16_t* Kb; bf16_t* Vb; const float* rope; const float* rowsq; const float* beta;
    __device__ __forceinline__ void operator()(const AccT& acc, const Unit& u, int wr, int wc, int fr, int fq) const {
        const int b = u.pm / 17, pt = u.pm % 17; const bool isctx = pt == 0;
        if (u.pn < 4 && isctx) return;
        const float* bt = beta + (size_t)(isctx ? 4 : b) * 1536 + u.pn * BM + wc * 32 + 8 * fq;
        float be1[8], be2[8];
#pragma unroll
        for (int e = 0; e < 8; ++e) { be1[e] = bt[e]; be2[e] = bt[HALF + e]; }
        float rsv[2][4];
#pragma unroll
        for (int ai = 0; ai < 2; ++ai)
#pragma unroll
            for (int m = 0; m < 4; ++m) rsv[ai][m] = rsqrtf(rowsq[(size_t)u.pm * BM + ai * HALF + wr * 64 + m * 16 + fr] * (1.0f / 1024.0f) + 1e-6f);
#pragma unroll
        for (int ai = 0; ai < 2; ++ai)
#pragma unroll
            for (int m = 0; m < 4; ++m) {
                const int rl = ai * HALF + wr * 64 + m * 16 + fr;
                const size_t row = (size_t)u.pm * BM + rl;
                float x1[8], x2[8];
                const float rs = rsv[ai][m];
#pragma unroll
                for (int e = 0; e < 8; ++e) { x1[e] = acc[ai][0][m][e >> 2][e & 3] * rs + be1[e]; x2[e] = acc[ai][1][m][e >> 2][e & 3] * rs + be2[e]; }
                if (u.pn < 5 && !isctx) {
                    const float* rp = rope + ((size_t)((pt - 1) * 256 + rl) * 32 + 8 * fq) * 2;
                    const float sc = u.pn < 4 ? 0.125f : 1.0f;
#pragma unroll
                    for (int e2 = 0; e2 < 4; ++e2) { const f32x4 cs = *(const f32x4*)(rp + e2 * 4);
                        { const float a = x1[2 * e2], bb = x2[2 * e2]; x1[2 * e2] = (a * cs[0] - bb * cs[1]) * sc; x2[2 * e2] = (bb * cs[0] + a * cs[1]) * sc; }
                        { const float a = x1[2 * e2 + 1], bb = x2[2 * e2 + 1]; x1[2 * e2 + 1] = (a * cs[2] - bb * cs[3]) * sc; x2[2 * e2 + 1] = (bb * cs[2] + a * cs[3]) * sc; } }
                }
                u32x4 w1, w2; w1.x = cvt_pk_bf16(x1[0], x1[1]); w1.y = cvt_pk_bf16(x1[2], x1[3]); w1.z = cvt_pk_bf16(x1[4], x1[5]); w1.w = cvt_pk_bf16(x1[6], x1[7]);
                w2.x = cvt_pk_bf16(x2[0], x2[1]); w2.y = cvt_pk_bf16(x2[2], x2[3]); w2.z = cvt_pk_bf16(x2[4], x2[5]); w2.w = cvt_pk_bf16(x2[6], x2[7]);
                bf16_t* op; if (u.pn < 4) op = Q + row * DM + (u.pn * 4 + wc) * 64; else { op = Kb + (u.pn == 4 ? (size_t)0 : (size_t)(OFF_V - OFF_K) / 2) + row * 256 + wc * 64; }
                *(u32x4*)(op + 8 * fq) = w1; *(u32x4*)(op + 32 + 8 * fq) = w2;
            }
    }
};
}

__device__ __forceinline__ int next_ticket(unsigned* ctr, volatile LAS unsigned* slot) {
    __syncthreads();
    if (threadIdx.x == 0) *slot = __hip_atomic_fetch_add(ctr, 1u, __ATOMIC_RELAXED, __HIP_MEMORY_SCOPE_AGENT);
    __syncthreads();
    return (int)*slot;
}
template <int MAP> __device__ __forceinline__ int colmap(int n) {
    if (MAP == 1) { const int pn = n >> 8, bj = (n >> 7) & 1, x = n & 127; return bj * DFF + pn * 128 + x; }
    if (MAP == 2) { const int pn = n >> 8, half = (n >> 7) & 1, hl = (n >> 5) & 3, rest = n & 31; return pn * 256 + hl * 64 + half * 32 + rest; }
    return n;
}
template <int MAP> __device__ __forceinline__ void convert_T(const float* src, int K, int N, int nrows, bf16_t* dst, int ldd, LAS float* tile, int& tbase, int vb, int vg) {
    const int tid = otid(), nkt = K / 64, ntiles = nkt * (nrows / 64);
    int first = vb - (tbase % vg); if (first < 0) first += vg;
    for (int tl = first; tl < ntiles; tl += vg) {
        const int n0 = (tl / nkt) * 64, k0 = (tl % nkt) * 64;
        __syncthreads();
#pragma unroll
        for (int e = 0; e < 8; ++e) { const int idx = e * 512 + tid, kk = idx >> 6, nn = idx & 63; tile[kk * 65 + nn] = src[(size_t)(k0 + kk) * N + colmap<MAP>(n0 + nn)]; }
        __syncthreads();
#pragma unroll
        for (int e = 0; e < 4; ++e) { const int idx = e * 512 + tid, nn = idx >> 5, kp = idx & 31;
            *(unsigned*)(dst + (size_t)(n0 + nn) * ldd + k0 + 2 * kp) = cvt_pk_bf16(tile[(2 * kp) * 65 + nn], tile[(2 * kp + 1) * 65 + nn]); }
    }
    tbase += ntiles;
}

__device__ __forceinline__ void p0_mods(const Params& p, LAS float* sl) {
    const int tid = otid();
    for (int i = tid; i < 5 * 1024; i += 512) { const int v = i >> 10, k = i & 1023; const float x = v < 4 ? PIN(1)[v * 1024 + k] : PIN(3)[k]; sl[i] = x / (1.0f + __expf(-x)); }
    LAS float* red = sl + 5 * 1024;
    float* mods = (float*)(p.ws + OFF_MODS);
    for (int chunk = blockIdx.x; chunk < 288; chunk += gridDim.x) {
        const int l = chunk / 144, col = (chunk % 144) * 64 + (tid & 63), kg = tid >> 6;
        const float* w = PIN(5) + (size_t)l * 1024 * 9216 + col;
        float a[5] = {0.f, 0.f, 0.f, 0.f, 0.f};
        __syncthreads();
        for (int k0 = kg * 128; k0 < kg * 128 + 128; k0 += 16) { float wv[16];
#pragma unroll
            for (int q = 0; q < 16; ++q) wv[q] = w[(size_t)(k0 + q) * 9216];
#pragma unroll
            for (int q = 0; q < 16; ++q)
#pragma unroll
                for (int v = 0; v < 5; ++v) a[v] += sl[v * 1024 + k0 + q] * wv[q]; }
#pragma unroll
        for (int v = 0; v < 5; ++v) red[(kg * 64 + (tid & 63)) * 5 + v] = a[v];
        __syncthreads();
        if (tid < 320) { const int v = tid / 64, cl = tid & 63; float s = 0.f;
#pragma unroll
            for (int q = 0; q < 8; ++q) s += red[(q * 64 + cl) * 5 + v];
            const int n = (chunk % 144) * 64 + cl;
            mods[((size_t)l * 5 + v) * 9216 + n] = s + PIN(6)[l * 9216 + n]; }
    }
    __syncthreads();
}

__device__ __forceinline__ void p0_rope(const Params& p) {
    float* rope = (float*)(p.ws + OFF_ROPE);
    for (int i = blockIdx.x * 512 + otid(); i < SEQ * 32; i += gridDim.x * 512) {
        const int t = i >> 5, j = i & 31;
        const float inv = powf(10000.0f, -(float)(j & 15) / 16.0f);
        const float pos = (float)(j < 16 ? (t >> 6) : (t & 63));
        const float ang = pos * inv; float s, c; sincosf(ang, &s, &c);
        rope[2 * i] = c; rope[2 * i + 1] = s;
    }
}

__device__ __forceinline__ void p0_s5ops(const Params& p, LAS float* sl) {
    const int tid = otid();
    LAS float* bbr = sl;
    LAS float* bbi = sl + 1024;
    LAS float* pwr = sl + 2048;
    LAS float* pwi = sl + 2112;
    LAS float* xs  = sl + 2176;
    LAS float* ths = sl + 2240;
    LAS float* cr  = sl + 2304;
    LAS float* ci  = sl + 3328;
    LAS float* red = sl + 4352;
    float* ktab = (float*)(p.ws + OFF_KTAB);
    bf16_t* KG = (bf16_t*)(p.ws + OFF_KG); bf16_t* Fm = (bf16_t*)(p.ws + OFF_F);
    for (int item4 = blockIdx.x; item4 < 256; item4 += gridDim.x) {
        const int item = item4 >> 2, tq = item4 & 3, tau_lo = tq == 0 ? 0 : tq * 8 + 1, tau_hi = tq * 8 + 8;
        const int g = item >> 1, d = item & 1, gd = d * 32 + g;
        __syncthreads();
        if (tid < 64) {
            const float lre = fminf(PIN(22)[gd * 64 + tid], -1e-4f), lim = PIN(23)[gd * 64 + tid], dt = __expf(PIN(24)[gd]);
            xs[tid] = lre * dt; ths[tid] = lim * dt;
        }
        for (int i = tid; i < 1024; i += 512) { cr[i] = PIN(27)[(size_t)gd * 1024 + i]; ci[i] = PIN(28)[(size_t)gd * 1024 + i]; }
        __syncthreads();
        for (int i = tid; i < 1024; i += 512) {
            const int pp = i >> 4;
            const float lre = fminf(PIN(22)[gd * 64 + pp], -1e-4f), lim = PIN(23)[gd * 64 + pp];
            const float x = xs[pp], th = ths[pp];
            float sn, cs; sincosf(th, &sn, &cs); const float mag = __expf(x);
            float sh, chh; sincosf(0.5f * th, &sh, &chh);
            const float am1r = expm1f(x) * cs - 2.0f * sh * sh, abi = mag * sn;
            const float den = lre * lre + lim * lim;
            const float fre = (am1r * lre + abi * lim) / den, fim = (abi * lre - am1r * lim) / den;
            const float br = PIN(25)[(size_t)gd * 1024 + i], bi = PIN(26)[(size_t)gd * 1024 + i];
            bbr[i] = fre * br - fim * bi; bbi[i] = fre * bi + fim * br;
        }
        for (int tau = tau_lo; tau <= tau_hi; ++tau) {
            __syncthreads();
            if (tid < 64) { const float mg = __expf((float)tau * xs[tid]); float sn, cs; sincosf((float)tau * ths[tid], &sn, &cs); pwr[tid] = mg * cs; pwi[tid] = mg * sn; }
            __syncthreads();
            if (tau < 32) {
                const int ij = tid & 255, i = ij >> 4, j = ij & 15, ph = tid >> 8; float s = 0.f;
                for (int pp = ph * 32; pp < ph * 32 + 32; ++pp) { const float qr = pwr[pp] * bbr[pp * 16 + j] - pwi[pp] * bbi[pp * 16 + j], qi = pwr[pp] * bbi[pp * 16 + j] + pwi[pp] * bbr[pp * 16 + j];
                    s += cr[i * 64 + pp] * qr - ci[i * 64 + pp] * qi; }
                red[tid] = s;
                const int sidx = d == 0 ? 31 - tau : tau;
                for (int q = tid; q < 1024; q += 512) { const int pp = q >> 4, jj = q & 15;
                    const float qr = pwr[pp] * bbr[q] - pwi[pp] * bbi[q], qi = pwr[pp] * bbi[q] + pwi[pp] * bbr[q];
                    bf16_t* fp = Fm + ((size_t)g * 256 + d * 128 + 2 * pp) * 512 + sidx * 16 + jj;
                    fp[0] = f2bf(qr); fp[512] = f2bf(qi); }
            }
            if (tau >= 1) {
                const int t = d == 0 ? tau - 1 : 32 - tau;
                for (int q = tid; q < 1024; q += 512) { const int i = q >> 6, pp = q & 63;
                    const float vr = cr[i * 64 + pp] * pwr[pp] - ci[i * 64 + pp] * pwi[pp], vi = cr[i * 64 + pp] * pwi[pp] + ci[i * 64 + pp] * pwr[pp];
                    *(unsigned*)(KG + ((size_t)g * 512 + t * 16 + i) * 768 + 512 + d * 128 + 2 * pp) = cvt_pk_bf16(vr, -vi); }
            }
            __syncthreads();
            if (tau < 32 && tid < 256) ktab[(((size_t)g * 2 + d) * 32 + tau) * 256 + tid] = red[tid] + red[tid + 256];
        }
    }
    __syncthreads();
}

__device__ __forceinline__ void p1_kg(const Params& p, int vb, int vg) {
    const float* ktab = (const float*)(p.ws + OFF_KTAB); bf16_t* KG = (bf16_t*)(p.ws + OFF_KG);
    const int k = otid(), s = k >> 4, j = k & 15;
    for (int row = vb; row < 32 * 512; row += vg) {
        const int g = row >> 9, m = row & 511, t = m >> 4, i = m & 15;
        const float* k0 = ktab + ((size_t)g * 2 + 0) * 32 * 256; const float* k1 = ktab + ((size_t)g * 2 + 1) * 32 * 256;
        float v;
        if (s < t) v = k0[(t - s) * 256 + i * 16 + j]; else if (s > t) v = k1[(s - t) * 256 + i * 16 + j]; else v = k0[i * 16 + j] + k1[i * 16 + j];
        KG[(size_t)row * 768 + k] = f2bf(v);
    }
}

__device__ __forceinline__ void phase_norm0(const Params& p) {
    const int tid_ = otid(); const int wid = tid_ >> 6, lane = tid_ & 63;
    const float* gw = PIN(4);
    bf16_t* A = (bf16_t*)(p.ws + OFF_A); float* rowsq = (float*)(p.ws + OFF_ROWSQ);
    const int half = gridDim.x * 8;
    for (int r = blockIdx.x * 8 + wid; r < MR; r += 2 * half) {
        const int r2 = (r + half < MR) ? r + half : r;
        const int b = r / LT, t = r - b * LT, b2 = r2 / LT, t2 = r2 - b2 * LT;
        const float* src = in_row(p, b, t); const float* src2 = in_row(p, b2, t2);
        const float* md = (const float*)(p.ws + OFF_MODS) + (size_t)(t < LC ? 4 : b) * 9216;
        const float* md2 = (const float*)(p.ws + OFF_MODS) + (size_t)(t2 < LC ? 4 : b2) * 9216;
        f32x4 v[4], w[4]; float ss = 0.f, ss2 = 0.f;
#pragma unroll
        for (int i = 0; i < 4; ++i) { v[i] = *(const f32x4*)(src + i * 256 + lane * 4); w[i] = *(const f32x4*)(src2 + i * 256 + lane * 4); }
#pragma unroll
        for (int i = 0; i < 4; ++i) { ss += v[i][0] * v[i][0] + v[i][1] * v[i][1] + v[i][2] * v[i][2] + v[i][3] * v[i][3]; ss2 += w[i][0] * w[i][0] + w[i][1] * w[i][1] + w[i][2] * w[i][2] + w[i][3] * w[i][3]; }
        for (int o = 32; o >= 1; o >>= 1) { ss += __shfl_xor(ss, o); ss2 += __shfl_xor(ss2, o); }
        if (lane == 0) { rowsq[r] = ss; if (r2 != r) rowsq[r2] = ss2; }
#pragma unroll
        for (int i = 0; i < 4; ++i) { const int c = i * 256 + lane * 4;
            const f32x4 g4 = *(const f32x4*)(gw + c), sc = *(const f32x4*)(md + 1024 + c), sc2 = *(const f32x4*)(md2 + 1024 + c);
            const f32x4 o = v[i] * g4 * (sc + 1.0f), o2 = w[i] * g4 * (sc2 + 1.0f);
            u32x2 q; q.x = cvt_pk_bf16(o[0], o[1]); q.y = cvt_pk_bf16(o[2], o[3]);
            *(u32x2*)(A + (size_t)r * DM + c) = q;
            if (r2 != r) { u32x2 q2; q2.x = cvt_pk_bf16(o2[0], o2[1]); q2.y = cvt_pk_bf16(o2[2], o2[3]); *(u32x2*)(A + (size_t)r2 * DM + c) = q2; } }
    }
}
__device__ __forceinline__ void p1_gam(const Params& p) {
    float* gam = (float*)(p.ws + OFF_GAM); const float* mods = (const float*)(p.ws + OFF_MODS); const float* ng = PIN(4);
    for (int i = blockIdx.x * 512 + otid(); i < 6 * 5 * 1024; i += gridDim.x * 512) {
        const int c = i & 1023, v = (i >> 10) % 5, j = i / 5120, l = j / 3, which = j % 3;
        gam[i] = ng[(size_t)j * 1024 + c] * (1.0f + mods[((size_t)l * 5 + v) * 9216 + (3 * which + 1) * 1024 + c]);
    }
}
template <int MAP> __device__ __forceinline__ void beta_gemv(const Params& p, const float* W, int N, int j, LAS float* sl, int& cbase, int vb, int vg) {
    const int tid = otid(), l = j / 3, which = j % 3;
    const float* mods = (const float*)(p.ws + OFF_MODS); float* beta = (float*)(p.ws + OFF_BETA) + (size_t)j * 5 * 5632;
    __syncthreads();
    for (int i = tid; i < 5 * 1024; i += 512) sl[i] = mods[((size_t)l * 5 + (i >> 10)) * 9216 + (3 * which) * 1024 + (i & 1023)];
    LAS float* red = sl + 5 * 1024;
    const int nch = N / 64;
    int first = vb - (cbase % vg); if (first < 0) first += vg;
    for (int chunk = first; chunk < nch; chunk += vg) {
        const int cl = tid & 63, kg = tid >> 6, np = chunk * 64 + cl;
        const float* w = W + colmap<MAP>(np);
        float a[5] = {0.f, 0.f, 0.f, 0.f, 0.f};
        __syncthreads();
        for (int k0 = kg * 128; k0 < kg * 128 + 128; k0 += 16) { float wv[16];
#pragma unroll
            for (int q = 0; q < 16; ++q) wv[q] = w[(size_t)(k0 + q) * N];
#pragma unroll
            for (int q = 0; q < 16; ++q)
#pragma unroll
                for (int v = 0; v < 5; ++v) a[v] += sl[v * 1024 + k0 + q] * wv[q]; }
#pragma unroll
        for (int v = 0; v < 5; ++v) red[(kg * 64 + cl) * 5 + v] = a[v];
        __syncthreads();
        if (tid < 320) { const int v = tid / 64, c2 = tid & 63; float sacc = 0.f;
#pragma unroll
            for (int q = 0; q < 8; ++q) sacc += red[(q * 64 + c2) * 5 + v];
            beta[(size_t)v * N + chunk * 64 + c2] = sacc; }
    }
    cbase += nch;
    __syncthreads();
}

__device__ __forceinline__ void phase_final(const Params& p) {
    const int tid_ = otid(); const int wid = tid_ >> 6, lane = tid_ & 63;
    const float* gw = PIN(35);
    const int half = gridDim.x * 8;
    for (int r = blockIdx.x * 8 + wid; r < NB * SEQ; r += 2 * half) {
        const int r2 = (r + half < NB * SEQ) ? r + half : r;
        float* row = p.out + (size_t)r * DM; float* row2 = p.out + (size_t)r2 * DM;
        f32x4 v[4], w[4]; float ss = 0.f, ss2 = 0.f;
#pragma unroll
        for (int i = 0; i < 4; ++i) { v[i] = *(const f32x4*)(row + i * 256 + lane * 4); w[i] = *(const f32x4*)(row2 + i * 256 + lane * 4); }
#pragma unroll
        for (int i = 0; i < 4; ++i) { ss += v[i][0] * v[i][0] + v[i][1] * v[i][1] + v[i][2] * v[i][2] + v[i][3] * v[i][3]; ss2 += w[i][0] * w[i][0] + w[i][1] * w[i][1] + w[i][2] * w[i][2] + w[i][3] * w[i][3]; }
        for (int o = 32; o >= 1; o >>= 1) { ss += __shfl_xor(ss, o); ss2 += __shfl_xor(ss2, o); }
        const float rstd = rsqrtf(ss * (1.0f / 1024.0f) + 1e-6f), rstd2 = rsqrtf(ss2 * (1.0f / 1024.0f) + 1e-6f);
#pragma unroll
        for (int i = 0; i < 4; ++i) { const int c = i * 256 + lane * 4; const f32x4 g4 = *(const f32x4*)(gw + c);
            *(f32x4*)(row + c) = v[i] * rstd * g4; if (r2 != r) *(f32x4*)(row2 + c) = w[i] * rstd2 * g4; }
    }
}

__device__ __forceinline__ void phase_mixprep(const Params& p) {
    const int tid_ = otid(); const int wid = tid_ >> 6, lane = tid_ & 63;
    const bf16_t* P = (const bf16_t*)(p.ws + OFF_P); bf16_t* AL = (bf16_t*)(p.ws + OFF_ALORA); bf16_t* UX = (bf16_t*)(p.ws + OFF_UX);
    const float* mu0 = PIN(11); const float* mu1 = PIN(11) + 1792;
    unsigned short* MIX = (unsigned short*)(p.ws + OFF_MIX);
    float m0c[3][8], m1c[3][8], kkc[8];
#pragma unroll
    for (int q = 0; q < 3; ++q)
#pragma unroll
        for (int e = 0; e < 8; ++e) { m0c[q][e] = mu0[q * 512 + lane * 8 + e]; m1c[q][e] = mu1[q * 512 + lane * 8 + e]; }
#pragma unroll
    for (int e = 0; e < 8; ++e) kkc[e] = PIN(17)[lane * 8 + e];
    struct MixIn { u32x2 cw, pw, nw; u32x4 uw, c[3], pv[3], nx[3]; };
    const int c = 1536 + lane * 4;
    const f32x4 m0 = *(const f32x4*)(mu0 + c), m1 = *(const f32x4*)(mu1 + c);
#define MIX_LOAD(D, R) do { const int t_ = (R) % LT; const int op_ = (t_ != 0 && t_ != LC) ? 2304 : 0, on_ = (t_ != LC - 1 && t_ != LT - 1) ? 2304 : 0; \
        const bf16_t* pr_ = P + (size_t)(R) * 2304; \
        D.cw = *(const u32x2*)(pr_ + c); D.pw = *(const u32x2*)(pr_ + c - op_); D.nw = *(const u32x2*)(pr_ + c + on_); D.uw = *(const u32x4*)(pr_ + 1792 + lane * 8); \
        _Pragma("unroll") for (int q = 0; q < 3; ++q) { const bf16_t* pq_ = pr_ + q * 512 + lane * 8; D.c[q] = *(const u32x4*)pq_; D.pv[q] = *(const u32x4*)(pq_ - op_); D.nx[q] = *(const u32x4*)(pq_ + on_); } } while (0)
    const int r0 = blockIdx.x * 8 + wid, rstride = gridDim.x * 8;
    MixIn cur; if (r0 < MR) MIX_LOAD(cur, r0);
    for (int r = r0; r < MR; r += rstride) {
        MixIn nxt = cur; if (r + rstride < MR) MIX_LOAD(nxt, r + rstride);
        const int b = r / LT, t = r - b * LT;
        const float fpv = (t != 0 && t != LC) ? 1.0f : 0.0f, fnv = (t != LC - 1 && t != LT - 1) ? 1.0f : 0.0f;
        float x[4] = {lo_bf(cur.cw.x), hi_bf(cur.cw.x), lo_bf(cur.cw.y), hi_bf(cur.cw.y)};
        const float pv[4] = {lo_bf(cur.pw.x), hi_bf(cur.pw.x), lo_bf(cur.pw.y), hi_bf(cur.pw.y)}, nv[4] = {lo_bf(cur.nw.x), hi_bf(cur.nw.x), lo_bf(cur.nw.y), hi_bf(cur.nw.y)};
#pragma unroll
        for (int e = 0; e < 4; ++e) { const float v = x[e] + m0[e] * (fpv * pv[e] - x[e]) + m1[e] * (fnv * nv[e] - x[e]);
            x[e] = lane < 16 ? tanhf(v) : (lane < 32 ? v : sigmoidf_(v)); }
        u32x2 w; w.x = cvt_pk_bf16(x[0], x[1]); w.y = cvt_pk_bf16(x[2], x[3]);
        *(u32x2*)(AL + (size_t)r * 256 + lane * 4) = w;
        const int g = lane >> 1, n = b * NCH + (t >> 5), tt = t & 31;
        *(u32x4*)(UX + ((size_t)g * NROWS_G + n) * 768 + tt * 16 + (lane & 1) * 8) = cur.uw;
        float rk[3][8];
#pragma unroll
        for (int q = 0; q < 3; ++q) {
            const unsigned ca[4] = {cur.c[q].x, cur.c[q].y, cur.c[q].z, cur.c[q].w}, pa[4] = {cur.pv[q].x, cur.pv[q].y, cur.pv[q].z, cur.pv[q].w}, na[4] = {cur.nx[q].x, cur.nx[q].y, cur.nx[q].z, cur.nx[q].w};
#pragma unroll
            for (int e = 0; e < 4; ++e) { const float c0 = lo_bf(ca[e]), c1 = hi_bf(ca[e]);
                rk[q][2 * e] = c0 + m0c[q][2 * e] * (fpv * lo_bf(pa[e]) - c0) + m1c[q][2 * e] * (fnv * lo_bf(na[e]) - c0);
                rk[q][2 * e + 1] = c1 + m0c[q][2 * e + 1] * (fpv * hi_bf(pa[e]) - c1) + m1c[q][2 * e + 1] * (fnv * hi_bf(na[e]) - c1); }
            u32x4 wq; wq.x = pk_h16(rk[q][0], rk[q][1]); wq.y = pk_h16(rk[q][2], rk[q][3]); wq.z = pk_h16(rk[q][4], rk[q][5]); wq.w = pk_h16(rk[q][6], rk[q][7]);
            *(u32x4*)(MIX + (size_t)q * MR * 512 + (size_t)r * 512 + lane * 8) = wq;
        }
        float kx[8], ss = 0.f;
#pragma unroll
        for (int e = 0; e < 8; ++e) { kx[e] = rk[1][e] * kkc[e]; ss += kx[e] * kx[e]; }
        ss += dpp_mov<0xB1>(ss); ss += dpp_mov<0x4E>(ss); ss += dpp_mov<0x141>(ss);
        const float rn = rsqrtf(fmaxf(ss, 1e-12f));
        u32x4 wk; wk.x = pk_h16(kx[0] * rn, kx[1] * rn); wk.y = pk_h16(kx[2] * rn, kx[3] * rn); wk.z = pk_h16(kx[4] * rn, kx[5] * rn); wk.w = pk_h16(kx[6] * rn, kx[7] * rn);
        *(u32x4*)(MIX + (size_t)3 * MR * 512 + (size_t)r * 512 + lane * 8) = wk;
        cur = nxt;
    }
#undef MIX_LOAD
}

__device__ __forceinline__ void phase_s5carry(const Params& p) {
    const int tid_ = otid();
    if (tid_ >= 64) return;
    for (int gi = blockIdx.x * 64 + tid_; gi < NB * 32 * 2 * 64; gi += gridDim.x * 64) {
    const int pp = gi & 63, d = (gi >> 6) & 1, g = (gi >> 7) & 31, b = gi >> 12, gd = d * 32 + g;
    const float lre = fminf(PIN(22)[gd * 64 + pp], -1e-4f), lim = PIN(23)[gd * 64 + pp], dt = __expf(PIN(24)[gd]);
    const float mg = __expf(32.0f * lre * dt); float sn, cs; sincosf(32.0f * lim * dt, &sn, &cs);
    const float ar = mg * cs, ai = mg * sn;
    const float* E = (const float*)(p.ws + OFF_E); bf16_t* UX = (bf16_t*)(p.ws + OFF_UX);
    float xr = 0.f, xi = 0.f;
    for (int s0 = 0; s0 < NCH; s0 += 17) {
        f32x2 e[17]; size_t nn[17];
#pragma unroll
        for (int q = 0; q < 17; ++q) { const int s = s0 + q; const int c = d == 0 ? s : (s < 8 ? 7 - s : 143 - s);
            nn[q] = (size_t)g * NROWS_G + b * NCH + c; e[q] = *(const f32x2*)(E + nn[q] * 256 + d * 128 + 2 * pp); }
#pragma unroll
        for (int q = 0; q < 17; ++q) {
            *(unsigned*)(UX + nn[q] * 768 + 512 + d * 128 + 2 * pp) = cvt_pk_bf16(xr, xi);
            const float nr = ar * xr - ai * xi + e[q][0], ni = ar * xi + ai * xr + e[q][1];
            xr = nr; xi = ni;
        }
    }
    }
}

struct ScanBuf { float w[32][64]; unsigned kb[32][16][4], tr[32][16][4]; float vv[32][16]; };
constexpr int SCAN_YOFF = 2 * 26624;
struct ScanRaw { u32x4 c[4], aw, lw; };
struct ScanConst { float ka[8]; };
__device__ __forceinline__ int scan_tok(int d, int s) { return d == 0 ? s : (s < LC ? LC - 1 - s : (LT + LC - 1) - s); }
__device__ __forceinline__ void scan_issue(const Params& p, ScanRaw& R, int b, int h, int d, int chunk, int lt) {
    const unsigned short* MIX = (const unsigned short*)(p.ws + OFF_MIX);
    const unsigned short* AD = (const unsigned short*)(p.ws + OFF_LWA + (size_t)(2 + d) * SZ512);
    const unsigned short* LW = (const unsigned short*)(p.ws + OFF_LWA + (size_t)d * SZ512);
    const int tt = lt >> 3, cg = lt & 7, tok = scan_tok(d, chunk * 32 + tt);
    const size_t o = ((size_t)b * LT + tok) * 512 + h * 64 + cg * 8;
#pragma unroll
    for (int q = 0; q < 4; ++q) R.c[q] = *(const u32x4*)(MIX + (size_t)q * MR * 512 + o);
    R.aw = *(const u32x4*)(AD + o); R.lw = *(const u32x4*)(LW + o);
}
__device__ __forceinline__ void scan_finish(const ScanRaw& R, const ScanConst& C, LAS ScanBuf* sb, int rq, int lt, int d, int chunk) {
    const int tt = lt >> 3, cg = lt & 7;
    float rkv[4][8];
#pragma unroll
    for (int q = 0; q < 4; ++q) { const unsigned wa[4] = {R.c[q].x, R.c[q].y, R.c[q].z, R.c[q].w};
#pragma unroll
        for (int e = 0; e < 4; ++e) { rkv[q][2 * e] = lo_h(wa[e]); rkv[q][2 * e + 1] = hi_h(wa[e]); } }
    const unsigned awa[4] = {R.aw.x, R.aw.y, R.aw.z, R.aw.w}, lwa[4] = {R.lw.x, R.lw.y, R.lw.z, R.lw.w};
    float o_w[8], o_b[8], o_k[8];
#pragma unroll
    for (int e = 0; e < 8; ++e) {
        const float a = (e & 1) ? hi_h(awa[e >> 1]) : lo_h(awa[e >> 1]);
        const float lwv = (e & 1) ? hi_h(lwa[e >> 1]) : lo_h(lwa[e >> 1]);
        o_w[e] = __expf(lwv); o_b[e] = -rkv[3][e] * a;     o_k[e] = rkv[1][e] * (1.0f + (a - 1.0f) * C.ka[e]);
    }
    LAS float* d1 = &sb->w[tt][cg * 8];  *(LAS f32x4*)d1 = (f32x4){o_w[0], o_w[1], o_w[2], o_w[3]};     *(LAS f32x4*)(d1 + 4) = (f32x4){o_w[4], o_w[5], o_w[6], o_w[7]};
#pragma unroll
    for (int pc = 0; pc < 2; ++pc) {
        u32x4 kbv, trv;
        kbv.x = pk_h16(rkv[3][4 * pc], rkv[3][4 * pc + 1]); kbv.y = pk_h16(rkv[3][4 * pc + 2], rkv[3][4 * pc + 3]); kbv.z = pk_h16(o_b[4 * pc], o_b[4 * pc + 1]); kbv.w = pk_h16(o_b[4 * pc + 2], o_b[4 * pc + 3]);
        trv.x = pk_h16(o_k[4 * pc], o_k[4 * pc + 1]); trv.y = pk_h16(o_k[4 * pc + 2], o_k[4 * pc + 3]); trv.z = pk_h16(rkv[0][4 * pc], rkv[0][4 * pc + 1]); trv.w = pk_h16(rkv[0][4 * pc + 2], rkv[0][4 * pc + 3]);
        *(LAS u32x4*)&sb->kb[tt][2 * cg + pc][0] = kbv; *(LAS u32x4*)&sb->tr[tt][2 * cg + pc][0] = trv;
    }
    if ((cg >> 1) == rq) { LAS float* d5 = &sb->vv[tt][(cg & 1) * 8]; *(LAS f32x4*)d5 = (f32x4){rkv[2][0], rkv[2][1], rkv[2][2], rkv[2][3]}; *(LAS f32x4*)(d5 + 4) = (f32x4){rkv[2][4], rkv[2][5], rkv[2][6], rkv[2][7]}; }
}
__device__ __forceinline__ void scan_store_y(bf16_t* Y, const LAS float* yp, int b, int h, int d, int rq, int cy, int lt) {
    const int tt = lt >> 3, pr2 = lt & 7, tok = scan_tok(d, cy * 32 + tt);
    const LAS float* base = yp + (cy & 1) * 8192 + tt * 256;
    float o[2];
#pragma unroll
    for (int q = 0; q < 2; ++q) { const int row = pr2 * 2 + q; const LAS f32x4* v = (const LAS f32x4*)(base + (row >> 2) * 64 + (row & 3) * 16);
        const f32x4 a = v[0] + v[1] + v[2] + v[3]; o[q] = (a[0] + a[1]) + (a[2] + a[3]); }
    *(unsigned*)(Y + ((size_t)b * LT + tok) * 512 + h * 64 + rq * 16 + pr2 * 2) = cvt_pk_bf16(o[0], o[1]);
}
struct StepOps { f32x4 w4; u32x4 kb, tr; float vv; };
__device__ __forceinline__ void phase_scan(const Params& p, LAS unsigned char* lds) {
    const int tid = otid();
    LAS ScanBuf* sb = (LAS ScanBuf*)lds;
    LAS float* yp = (LAS float*)(lds + SCAN_YOFF);
    for (int qi = blockIdx.x; qi < 256; qi += gridDim.x) {
    const int xcd = qi & 7, j = qi >> 3, chain = xcd * 8 + (j >> 2), rq = j & 3;
    const int b = chain >> 4, h = (chain >> 1) & 7, d = chain & 1;
    bf16_t* Y = (bf16_t*)(p.ws + OFF_A) + (size_t)d * MR * 512;
    const bool loader = tid >= 256; const int lt = tid - 256;
    if (loader) {
        ScanConst C; ScanRaw R;
        { const int ch = h * 64 + (lt & 7) * 8;
#pragma unroll
          for (int e = 0; e < 8; ++e) C.ka[e] = PIN(18)[ch + e]; }
        scan_issue(p, R, b, h, d, 0, lt); scan_finish(R, C, sb, rq, lt, d, 0);
        ScanRaw R2;
        scan_issue(p, R, b, h, d, 1, lt);
        scan_issue(p, R2, b, h, d, 2, lt);
        LDS_BARRIER();
        for (int c = 0; c < NCH; c += 2) {
            const int c1 = c + 1, c2 = (c + 2 < NCH) ? c + 2 : NCH - 1, c3 = (c + 3 < NCH) ? c + 3 : NCH - 1, c4 = (c + 4 < NCH) ? c + 4 : NCH - 1, cm = c >= 1 ? c - 1 : 0;
            scan_finish(R, C, sb + (c1 & 1), rq, lt, d, c1);
            scan_issue(p, R, b, h, d, c3, lt);
            scan_store_y(Y, yp, b, h, d, rq, cm, lt);
            LDS_BARRIER();
            scan_finish(R2, C, sb + ((c + 2) & 1), rq, lt, d, c2);
            scan_issue(p, R2, b, h, d, c4, lt);
            scan_store_y(Y, yp, b, h, d, rq, c, lt);
            LDS_BARRIER();
        }
        scan_store_y(Y, yp, b, h, d, rq, NCH - 1, lt);
    } else {
        const int lane = tid & 63, wv = tid >> 6, rowl = lane >> 4, kq = lane & 15, row = wv * 4 + rowl;
        float s0 = 0.f, s1 = 0.f, s2 = 0.f, s3 = 0.f; float zf = 0.f; asm volatile("" : "+v"(zf));
        LDS_BARRIER();
#define SC_LOAD(o, st) do { o.w4 = *(const LAS f32x4*)&cb->w[st][kq * 4]; o.kb = *(const LAS u32x4*)&cb->kb[st][kq][0]; o.tr = *(const LAS u32x4*)&cb->tr[st][kq][0]; o.vv = cb->vv[st][row]; } while (0)
          \
#define SC_STEP(o, rp, st) do { \
        float t0 = mixlo(o.kb.x, s0, zf), q0 = mixlo(rp.z, s0, zf), t1 = mixhi(o.kb.x, s1, zf), q1 = mixhi(rp.z, s1, zf); \
        t0 = mixlo(o.kb.y, s2, t0); q0 = mixlo(rp.w, s2, q0); t1 = mixhi(o.kb.y, s3, t1); q1 = mixhi(rp.w, s3, q1); \
        const float p0 = s0 * o.w4[0], p1 = s1 * o.w4[1], p2 = s2 * o.w4[2], p3 = s3 * o.w4[3]; \
        const float u0 = mixlo(o.tr.x, o.vv, p0), u1 = mixhi(o.tr.x, o.vv, p1), u2 = mixlo(o.tr.y, o.vv, p2), u3 = mixhi(o.tr.y, o.vv, p3); \
        const float sk = allreduce16(t0 + t1); \
        if ((st) > 0) yo[((st) - 1) * 256 + (tid & 255)] = q0 + q1; \
        s0 = mixlo(o.kb.z, sk, u0); s1 = mixhi(o.kb.z, sk, u1); s2 = mixlo(o.kb.w, sk, u2); s3 = mixhi(o.kb.w, sk, u3); } while (0)
        for (int c = 0; c < NCH; ++c) {
            const LAS ScanBuf* cb = sb + (c & 1);
            LAS float* yo = yp + (c & 1) * 8192;
            StepOps A, B, C4, D4;
            D4.tr = (u32x4){0u, 0u, 0u, 0u};
            SC_LOAD(A, 0); SC_LOAD(B, 1);
#pragma unroll
            for (int st = 0; st < 32; st += 4) {
                SC_LOAD(C4, st + 2); SC_STEP(A, D4.tr, st);
                SC_LOAD(D4, st + 3); SC_STEP(B, A.tr, st + 1);
                if (st + 4 < 32) SC_LOAD(A, st + 4);
                SC_STEP(C4, B.tr, st + 2);
                if (st + 5 < 32) SC_LOAD(B, st + 5);
                SC_STEP(D4, C4.tr, st + 3);
            }
            { const float q0 = mixlo(D4.tr.w, s2, mixlo(D4.tr.z, s0, zf)), q1 = mixhi(D4.tr.w, s3, mixhi(D4.tr.z, s1, zf)); yo[31 * 256 + (tid & 255)] = q0 + q1; }
            LDS_BARRIER();
        }
#undef SC_LOAD
#undef SC_STEP
    }
    __syncthreads();
    }
}

__device__ __forceinline__ void phase_rwkvpost(const Params& p) {
    const int tid_ = otid(); const int wid = tid_ >> 6, lane = tid_ & 63, sub = lane >> 4, l16 = lane & 15;
    const bf16_t* P = (const bf16_t*)(p.ws + OFF_P);
    const unsigned short* A0 = (const unsigned short*)(p.ws + OFF_LWA + 2 * SZ512); const unsigned short* A1 = (const unsigned short*)(p.ws + OFF_LWA + 3 * SZ512);
    const unsigned short* MIXP = (const unsigned short*)(p.ws + OFF_MIX);
    const unsigned short* G = (const unsigned short*)(p.ws + OFF_G);
    const bf16_t* Y0 = (const bf16_t*)(p.ws + OFF_A); const bf16_t* Y1 = Y0 + (size_t)MR * 512;
    bf16_t* CAT = (bf16_t*)(p.ws + OFF_CAT);
    const float* mu_ = PIN(11); const float* ka_ = PIN(18); const float* rk_ = PIN(19); const float* lg_ = PIN(20); const float* lb_ = PIN(21);
    struct PostIn { u32x2 c[3], a0w, a1w, gw, y0w, y1w; };
    const int stride = gridDim.x * 32, it0 = (blockIdx.x * 8 + wid) * 4 + sub;
#define POST_LOAD(D, IT) do { const int r_ = (IT) >> 3, ch_ = ((IT) & 7) * 64 + l16 * 4; const size_t o_ = (size_t)r_ * 512 + ch_; \
        D.c[0] = *(const u32x2*)(MIXP + o_); D.c[1] = *(const u32x2*)(MIXP + (size_t)MR * 512 + o_); D.c[2] = *(const u32x2*)(MIXP + (size_t)2 * MR * 512 + o_); \
        D.a0w = *(const u32x2*)(A0 + o_); D.a1w = *(const u32x2*)(A1 + o_); D.gw = *(const u32x2*)(G + o_); D.y0w = *(const u32x2*)(Y0 + o_); D.y1w = *(const u32x2*)(Y1 + o_); } while (0)
    PostIn cur; if (it0 < MR * 8) POST_LOAD(cur, it0);
    for (int it = it0; it < MR * 8; it += stride) {
        PostIn nxt = cur; if (it + stride < MR * 8) POST_LOAD(nxt, it + stride);
        const int r = it >> 3, h = it & 7;
        const int ch = h * 64 + l16 * 4;
        float rkv[3][4];
#pragma unroll
        for (int q = 0; q < 3; ++q) { rkv[q][0] = lo_h(cur.c[q].x); rkv[q][1] = hi_h(cur.c[q].x); rkv[q][2] = lo_h(cur.c[q].y); rkv[q][3] = hi_h(cur.c[q].y); }
        const u32x2 a0w = cur.a0w, a1w = cur.a1w, gw = cur.gw, y0w = cur.y0w, y1w = cur.y1w;
        const f32x4 ka = *(const f32x4*)(ka_ + ch), rk = *(const f32x4*)(rk_ + ch), lg = *(const f32x4*)(lg_ + ch), lb = *(const f32x4*)(lb_ + ch);
        const float a0[4] = {lo_h(a0w.x), hi_h(a0w.x), lo_h(a0w.y), hi_h(a0w.y)}, a1[4] = {lo_h(a1w.x), hi_h(a1w.x), lo_h(a1w.y), hi_h(a1w.y)}, gg[4] = {lo_h(gw.x), hi_h(gw.x), lo_h(gw.y), hi_h(gw.y)};
        const float y[4] = {lo_bf(y0w.x) + lo_bf(y1w.x), hi_bf(y0w.x) + hi_bf(y1w.x), lo_bf(y0w.y) + lo_bf(y1w.y), hi_bf(y0w.y) + hi_bf(y1w.y)};
        float sy = 0.f, sb = 0.f;
#pragma unroll
        for (int e = 0; e < 4; ++e) { const float ksum = rkv[1][e] * (2.0f + (a0[e] + a1[e] - 2.0f) * ka[e]); sy += y[e]; sb += rkv[0][e] * 0.5f * ksum * rk[e]; }
        const float mu = allreduce16(sy) * (1.0f / 64.0f), bs = allreduce16(sb);
        float sv = 0.f, dv[4];
#pragma unroll
        for (int e = 0; e < 4; ++e) { dv[e] = y[e] - mu; sv += dv[e] * dv[e]; }
        const float rstd = rsqrtf(allreduce16(sv) * (1.0f / 64.0f) + 64e-5f);
        float o[4];
#pragma unroll
        for (int e = 0; e < 4; ++e) o[e] = (dv[e] * rstd * lg[e] + lb[e] + bs * rkv[2][e]) * gg[e];
        u32x2 w; w.x = cvt_pk_bf16(o[0], o[1]); w.y = cvt_pk_bf16(o[2], o[3]);
        *(u32x2*)(CAT + (size_t)r * DM + ch) = w;
        cur = nxt;
    }
#undef POST_LOAD
}

__device__ __forceinline__ void phase_attn(const Params& p, LAS unsigned char* lds) {
    const int tid = otid(), wv = tid >> 6, lane = tid & 63, fr = lane & 15, fq = lane >> 4;
    const bf16_t* Q = (const bf16_t*)(p.ws + OFF_Q); const bf16_t* Kb = (const bf16_t*)(p.ws + OFF_K); const bf16_t* Vb = (const bf16_t*)(p.ws + OFF_V);
    bf16_t* O = (bf16_t*)(p.ws + OFF_O);
    LAS bf16_t* KL = (LAS bf16_t*)lds;
    LAS bf16_t* VL = (LAS bf16_t*)(lds + 2 * 64 * 72 * 2);
    for (int item = blockIdx.x; item < 1024; item += gridDim.x) {
        const int qt = item & 63, kvh = (item >> 6) & 3, b = item >> 8;
        const int i0 = qt * 64, hq = kvh * 4 + (wv >> 1), qsub = (wv & 1) * 32;
        const int wlo = (2 - qt) > 0 ? (2 - qt) : 0, whi = (65 - qt) < 4 ? (65 - qt) : 4, ntl = 4 + (whi - wlo + 1);
#define TL_POS(ti) ((ti) < 4 ? -100000 : i0 - 128 + 64 * (wlo + (ti) - 4))
#define TL_ROW(ti) ((ti) < 4 ? b * LT + (ti) * 64 : b * LT + LC + i0 - 128 + 64 * (wlo + (ti) - 4))
        bf16x8 qf[2][2];
#pragma unroll
        for (int mt = 0; mt < 2; ++mt)
#pragma unroll
            for (int ks = 0; ks < 2; ++ks) qf[mt][ks] = *(const bf16x8*)(Q + ((size_t)b * LT + LC + i0 + qsub + mt * 16 + fr) * DM + hq * 64 + ks * 32 + fq * 8);
        f32x4 oacc[2][4];
#pragma unroll
        for (int mt = 0; mt < 2; ++mt)
#pragma unroll
            for (int dt = 0; dt < 4; ++dt) oacc[mt][dt] = (f32x4){0.f, 0.f, 0.f, 0.f};
        const float sink = PIN(34)[hq];
        float mrun[2] = {sink, sink}, lrun[2] = {fq == 0 ? 1.0f : 0.0f, fq == 0 ? 1.0f : 0.0f};
        const int skey = tid >> 3, sdg = tid & 7;
        u32x4 kreg = *(const u32x4*)(Kb + (size_t)(TL_ROW(0) + skey) * 256 + kvh * 64 + sdg * 8);
        u32x4 vreg = *(const u32x4*)(Vb + (size_t)(TL_ROW(0) + skey) * 256 + kvh * 64 + sdg * 8);
        LDS_BARRIER();
        for (int ti = 0; ti < ntl; ++ti) {
            LAS bf16_t* kl = KL + (ti & 1) * 64 * 72; LAS bf16_t* vl = VL + (ti & 1) * 64 * 72;
            *(LAS u32x4*)(kl + skey * 72 + sdg * 8) = kreg;
            { const unsigned va[4] = {vreg.x, vreg.y, vreg.z, vreg.w};
#pragma unroll
              for (int e = 0; e < 4; ++e) { vl[(sdg * 8 + 2 * e) * 72 + skey] = (bf16_t)(va[e] & 0xffffu); vl[(sdg * 8 + 2 * e + 1) * 72 + skey] = (bf16_t)(va[e] >> 16); } }
            if (ti + 1 < ntl) { kreg = *(const u32x4*)(Kb + (size_t)(TL_ROW(ti + 1) + skey) * 256 + kvh * 64 + sdg * 8); vreg = *(const u32x4*)(Vb + (size_t)(TL_ROW(ti + 1) + skey) * 256 + kvh * 64 + sdg * 8); }
            LDS_BARRIER();
            const int pos0 = TL_POS(ti);
            const bool edge = pos0 >= 0 && (pos0 < i0 - 64 || pos0 > i0 + 64);
            f32x4 sacc[2][4];
#pragma unroll
            for (int mt = 0; mt < 2; ++mt)
#pragma unroll
                for (int kt = 0; kt < 4; ++kt) sacc[mt][kt] = (f32x4){0.f, 0.f, 0.f, 0.f};
#pragma unroll
            for (int kt = 0; kt < 4; ++kt)
#pragma unroll
                for (int ks = 0; ks < 2; ++ks) { const bf16x8 kf = *(const LAS bf16x8*)(kl + (kt * 16 + fr) * 72 + ks * 32 + fq * 8);
#pragma unroll
                    for (int mt = 0; mt < 2; ++mt) sacc[mt][kt] = __builtin_amdgcn_mfma_f32_16x16x32_bf16(kf, qf[mt][ks], sacc[mt][kt], 0, 0, 0); }
            bf16x8 pb[2][2];
#pragma unroll
            for (int mt = 0; mt < 2; ++mt) {
                const int qi = i0 + qsub + mt * 16 + fr;
                float mx = -3.0e38f;
#pragma unroll
                for (int kt = 0; kt < 4; ++kt)
#pragma unroll
                    for (int jj = 0; jj < 4; ++jj) { const int kp = pos0 + kt * 16 + fq * 4 + jj; const int dlt = kp - qi;
                        float s = sacc[mt][kt][jj]; if (edge && (dlt > 128 || dlt < -128)) s = -1.0e30f; sacc[mt][kt][jj] = s; mx = fmaxf(mx, s); }
                mx = fmaxf(mx, __shfl_xor(mx, 16)); mx = fmaxf(mx, __shfl_xor(mx, 32));
                const float mnew = fmaxf(mrun[mt], mx), scl = __expf(mrun[mt] - mnew);
                mrun[mt] = mnew; float ls = 0.f;
                float pv[4][4];
#pragma unroll
                for (int kt = 0; kt < 4; ++kt)
#pragma unroll
                    for (int jj = 0; jj < 4; ++jj) { const float e = __expf(sacc[mt][kt][jj] - mnew); pv[kt][jj] = e; ls += e; }
                lrun[mt] = lrun[mt] * scl + ls;
#pragma unroll
                for (int dt = 0; dt < 4; ++dt) oacc[mt][dt] *= scl;
#pragma unroll
                for (int k2 = 0; k2 < 2; ++k2) { u32x4 w; w.x = cvt_pk_bf16(pv[2 * k2][0], pv[2 * k2][1]); w.y = cvt_pk_bf16(pv[2 * k2][2], pv[2 * k2][3]);
                    w.z = cvt_pk_bf16(pv[2 * k2 + 1][0], pv[2 * k2 + 1][1]); w.w = cvt_pk_bf16(pv[2 * k2 + 1][2], pv[2 * k2 + 1][3]); pb[mt][k2] = __builtin_bit_cast(bf16x8, w); }
            }
#pragma unroll
            for (int dt = 0; dt < 4; ++dt)
#pragma unroll
                for (int k2 = 0; k2 < 2; ++k2) { const LAS bf16_t* vp = vl + (dt * 16 + fr) * 72 + k2 * 32 + fq * 4;
                    const u32x2 lo = *(const LAS u32x2*)vp, hi = *(const LAS u32x2*)(vp + 16);
                    const u32x4 vw = {lo.x, lo.y, hi.x, hi.y}; const bf16x8 vf = __builtin_bit_cast(bf16x8, vw);
#pragma unroll
                    for (int mt = 0; mt < 2; ++mt) oacc[mt][dt] = __builtin_amdgcn_mfma_f32_16x16x32_bf16(vf, pb[mt][k2], oacc[mt][dt], 0, 0, 0); }
        }
#pragma unroll
        for (int mt = 0; mt < 2; ++mt) {
            float l = lrun[mt]; l += __shfl_xor(l, 16); l += __shfl_xor(l, 32);
            const float inv = 1.0f / l;
            bf16_t* op = O + ((size_t)b * LT + LC + i0 + qsub + mt * 16 + fr) * DM + hq * 64 + fq * 4;
#pragma unroll
            for (int dt = 0; dt < 4; ++dt) { const f32x4 o = oacc[mt][dt] * inv; u32x2 w; w.x = cvt_pk_bf16(o[0], o[1]); w.y = cvt_pk_bf16(o[2], o[3]); *(u32x2*)(op + dt * 16) = w; }
        }
    }
    __syncthreads();
}

__global__ void __launch_bounds__(512, 2) fwd_kernel(Params p) {
    extern __shared__ __attribute__((aligned(16))) unsigned char lds_raw[];
    LAS unsigned char* lds = (LAS unsigned char*)lds_raw;
    volatile LAS unsigned* misc = (volatile LAS unsigned*)(lds + MISC_OFF);
    if (threadIdx.x < 4) misc[threadIdx.x] = 0u;
    __syncthreads();
    XcdBarrier bar; bar.bar = (unsigned*)(p.ws + OFF_BAR); bar.x = 0; bar.st = misc;
    const bool one = (p.ph_hi - p.ph_lo) > 1;
    if (one) bar = xcd_barrier_post((unsigned*)(p.ws + OFF_BAR), misc);
    unsigned char* ws = p.ws;
    const int G = gridDim.x, cidx = blockIdx.x;
    const float* mods0 = (const float*)(ws + OFF_MODS); const float* mods1 = mods0 + 5 * 9216;
    float* XC = (float*)(ws + OFF_XC);
    int ph = 0;
#define PH_BEGIN if (ph >= p.ph_lo && ph < p.ph_hi) { for (int rep_ = 0; rep_ <= (int)((REP_MASK >> ph) & 1u); ++rep_) {
#define PH_END   if (ph + 1 < p.ph_hi) xcd_barrier(bar); } } ++ph;

    PH_BEGIN
        LAS float* sl = (LAS float*)lds;
        int tb = 0;
        for (int f = 0; f < 1; ++f) convert_T<1>(PIN(7) + (size_t)f * DM * 5632, DM, 5632, 5632, (bf16_t*)(ws + OFF_W1T0 + f * SZ_W1T), DM, sl, tb, (int)blockIdx.x, (int)gridDim.x);
        for (int f = 0; f < 1; ++f) convert_T<0>(PIN(8) + (size_t)f * DFF * DM, DFF, DM, DM, (bf16_t*)(ws + OFF_W2T0 + f * SZ_W2T), DFF, sl, tb, (int)blockIdx.x, (int)gridDim.x);
        convert_T<0>(PIN(9), DM, 2304, 2304, (bf16_t*)(ws + OFF_ABIN), DM, sl, tb, (int)blockIdx.x, (int)gridDim.x);
        convert_T<0>(PIN(10), DM, DM, DM, (bf16_t*)(ws + OFF_ABOUT), DM, sl, tb, (int)blockIdx.x, (int)gridDim.x);
        convert_T<0>(PIN(30), 512, 512, 512, (bf16_t*)(ws + OFF_GLU), 512, sl, tb, (int)blockIdx.x, (int)gridDim.x);
        for (int d = 0; d < 2; ++d) convert_T<0>(PIN(13) + (size_t)d * 64 * 512, 64, 512, 512, (bf16_t*)(ws + OFF_LORA) + (size_t)d * 512 * 256, 256, sl, tb, (int)blockIdx.x, (int)gridDim.x);
        for (int d = 0; d < 2; ++d) convert_T<0>(PIN(15) + (size_t)d * 64 * 512, 64, 512, 512, (bf16_t*)(ws + OFF_LORA) + (size_t)(1024 + d * 512) * 256 + 64, 256, sl, tb, (int)blockIdx.x, (int)gridDim.x);
        convert_T<0>(PIN(16), 128, 512, 512, (bf16_t*)(ws + OFF_LORA) + (size_t)2048 * 256 + 128, 256, sl, tb, (int)blockIdx.x, (int)gridDim.x);
        __syncthreads();
        p0_mods(p, sl);
        p0_rope(p);
        p0_s5ops(p, sl);
    PH_END
    PH_BEGIN
        phase_norm0(p); p1_gam(p);
        { LAS float* sl = (LAS float*)lds; int cb = 0; beta_gemv<1>(p, PIN(7), 5632, 0, sl, cb, (int)blockIdx.x, (int)gridDim.x); }
    PH_END
    float* RSQ = (float*)(ws + OFF_ROWSQ); const float* GAM = (const float*)(ws + OFF_GAM); const float* BETA = (const float*)(ws + OFF_BETA);
    bf16_t* ABUF = (bf16_t*)(ws + OFF_A);
#define RSQJ(j) (RSQ + (size_t)(j) * MR)
#define GAMJ(j) (GAM + (size_t)(j) * 5 * 1024)
#define BETAJ(j) (BETA + (size_t)(j) * 5 * 5632)
    PH_BEGIN { pg8::Gemm g{(const bf16_t*)(ws + OFF_A), (const bf16_t*)(ws + OFF_W1T0), DM, DM, DM}; pg8::Sched S; S.init(0, 68, 22, 1, 0, G, cidx);
               pg8::EpiSwiglu E{(bf16_t*)(ws + OFF_ACT), RSQJ(0), BETAJ(0)}; pg8::gemm_phase(lds, g, S, E); } PH_END
    PH_BEGIN { pg8::Gemm g{(const bf16_t*)(ws + OFF_ACT), (const bf16_t*)(ws + OFF_W2T0), DFF, DFF, DFF}; pg8::Sched S; S.init(0, 68, 4, 1, 0, G, cidx);
               pg8::EpiResid<true, true> E{PIN(0), PIN(2), p.out, XC, mods0, 2, ABUF, GAMJ(1), RSQJ(1)}; pg8::gemm_phase(lds, g, S, E); }
             {
               LAS float* sl = (LAS float*)lds; unsigned* ctr = (unsigned*)(ws + OFF_BAR) + 3520; int vb;
               while ((vb = next_ticket(ctr, misc + 8)) < 580) { int cb = 0; const int BIG = 1 << 20;
                   if (vb < 36) beta_gemv<0>(p, PIN(9), 2304, 1, sl, cb, vb, BIG);
                   else if (vb < 124) beta_gemv<1>(p, PIN(7) + (size_t)1 * DM * 5632, 5632, 2, sl, cb, vb - 36, BIG);
                   else if (vb < 212) beta_gemv<1>(p, PIN(7) + (size_t)2 * DM * 5632, 5632, 3, sl, cb, vb - 124, BIG);
                   else if (vb < 236) beta_gemv<2>(p, PIN(32), 1536, 4, sl, cb, vb - 212, BIG);
                   else if (vb < 324) beta_gemv<1>(p, PIN(7) + (size_t)3 * DM * 5632, 5632, 5, sl, cb, vb - 236, BIG);
                   else p1_kg(p, vb - 324, 256); } }
    PH_END
    PH_BEGIN { pg8::Gemm g{(const bf16_t*)(ws + OFF_A), (const bf16_t*)(ws + OFF_ABIN), DM, DM, DM}; pg8::Sched S; S.init(0, 68, 9, 1, 0, G, cidx);
               pg8::EpiStoreBf16 E{(bf16_t*)(ws + OFF_P), 2304, RSQJ(1), BETAJ(1), 2304}; pg8::gemm_phase(lds, g, S, E); } PH_END
    PH_BEGIN phase_mixprep(p); PH_END
    PH_BEGIN { { pg8::Gemm g{(const bf16_t*)(ws + OFF_ALORA), (const bf16_t*)(ws + OFF_LORA), 256, 256, 256}; pg8::Sched S; S.init(0, 68, 10, 1, 0, G, cidx);
                 pg8::EpiLora E{ws, PIN(12), PIN(14)}; pg8::gemm_phase(lds, g, S, E); }
               { pg8::Gemm g{(const bf16_t*)(ws + OFF_UX), (const bf16_t*)(ws + OFF_F), 512, 768, 512}; pg8::Sched S; S.init(2, 3, 1, 32, 256, G, cidx);
                 pg8::EpiE E{(float*)(ws + OFF_E)}; pg8::gemm_phase(lds, g, S, E); } } PH_END
    PH_BEGIN phase_scan(p, lds); PH_END
    PH_BEGIN phase_s5carry(p); phase_rwkvpost(p); PH_END
    PH_BEGIN { pg8::Gemm g{(const bf16_t*)(ws + OFF_UX), (const bf16_t*)(ws + OFF_KG), 768, 768, 768}; pg8::Sched S; S.init(2, 3, 2, 32, 512, G, cidx);
               pg8::EpiY E{(const bf16_t*)(ws + OFF_UX), PIN(29), (bf16_t*)(ws + OFF_A)}; pg8::gemm_phase(lds, g, S, E); } PH_END
    PH_BEGIN { pg8::Gemm g{(const bf16_t*)(ws + OFF_A), (const bf16_t*)(ws + OFF_GLU), 512, 512, 512}; pg8::Sched S; S.init(0, 68, 2, 1, 0, G, cidx);
               pg8::EpiGlu E{(const bf16_t*)(ws + OFF_A), PIN(31), (bf16_t*)(ws + OFF_CAT)}; pg8::gemm_phase(lds, g, S, E); } PH_END
    PH_BEGIN { pg8::Gemm g{(const bf16_t*)(ws + OFF_CAT), (const bf16_t*)(ws + OFF_ABOUT), DM, DM, DM}; pg8::Sched S; S.init(0, 68, 4, 1, 0, G, cidx);
               pg8::EpiResid<false, true> E{p.out, XC, p.out, XC, mods0, 5, ABUF, GAMJ(2), RSQJ(2)}; pg8::gemm_phase(lds, g, S, E); }
             {
               LAS float* sl = (LAS float*)lds; unsigned* ctr = (unsigned*)(ws + OFF_BAR) + 3648; int vb;
               while ((vb = next_ticket(ctr, misc + 8)) < 512) { int tb = 0;
                   convert_T<1>(PIN(7) + (size_t)1 * DM * 5632, DM, 5632, 5632, (bf16_t*)(ws + OFF_W1T0 + SZ_W1T), DM, sl, tb, vb, 512);
                   convert_T<0>(PIN(8) + (size_t)1 * DFF * DM, DFF, DM, DM, (bf16_t*)(ws + OFF_W2T0 + SZ_W2T), DFF, sl, tb, vb, 512); } }
    PH_END
    PH_BEGIN
        { pg8::Gemm g{(const bf16_t*)(ws + OFF_A), (const bf16_t*)(ws + OFF_W1T0 + SZ_W1T), DM, DM, DM}; pg8::Sched S; S.init(0, 68, 22, 1, 0, G, cidx);
          pg8::EpiSwiglu E{(bf16_t*)(ws + OFF_ACT), RSQJ(2), BETAJ(2)}; pg8::gemm_phase(lds, g, S, E); }
    PH_END
    PH_BEGIN { pg8::Gemm g{(const bf16_t*)(ws + OFF_ACT), (const bf16_t*)(ws + OFF_W2T0 + SZ_W2T), DFF, DFF, DFF}; pg8::Sched S; S.init(0, 68, 4, 1, 0, G, cidx);
               pg8::EpiResid<true, true> E{p.out, XC, p.out, XC, mods0, 8, ABUF, GAMJ(3), RSQJ(3)}; pg8::gemm_phase(lds, g, S, E); }
             {
               LAS float* sl = (LAS float*)lds; unsigned* ctr = (unsigned*)(ws + OFF_BAR) + 3584; int vb;
               while ((vb = next_ticket(ctr, misc + 8)) < 1024) { int tb = 0;
                   for (int f = 0; f < 2; ++f) convert_T<1>(PIN(7) + (size_t)(2 + f) * DM * 5632, DM, 5632, 5632, (bf16_t*)(ws + OFF_W1T1 + f * SZ_W1T), DM, sl, tb, vb, 1024);
                   for (int f = 0; f < 2; ++f) convert_T<0>(PIN(8) + (size_t)(2 + f) * DFF * DM, DFF, DM, DM, (bf16_t*)(ws + OFF_W2T1 + f * SZ_W2T), DFF, sl, tb, vb, 1024);
                   convert_T<2>(PIN(32), DM, 1536, 1536, (bf16_t*)(ws + OFF_ATTNIN), DM, sl, tb, vb, 1024);
                   convert_T<0>(PIN(33), DM, DM, DM, (bf16_t*)(ws + OFF_ATTNOUT), DM, sl, tb, vb, 1024); } }
    PH_END
    PH_BEGIN { pg8::Gemm g{(const bf16_t*)(ws + OFF_A), (const bf16_t*)(ws + OFF_W1T1), DM, DM, DM}; pg8::Sched S; S.init(0, 68, 22, 1, 0, G, cidx);
               pg8::EpiSwiglu E{(bf16_t*)(ws + OFF_ACT), RSQJ(3), BETAJ(3)}; pg8::gemm_phase(lds, g, S, E); } PH_END
    PH_BEGIN { pg8::Gemm g{(const bf16_t*)(ws + OFF_ACT), (const bf16_t*)(ws + OFF_W2T1), DFF, DFF, DFF}; pg8::Sched S; S.init(0, 68, 4, 1, 0, G, cidx);
               pg8::EpiResid<true, true> E{p.out, XC, p.out, XC, mods1, 2, ABUF, GAMJ(4), RSQJ(4)}; pg8::gemm_phase(lds, g, S, E); } PH_END
    PH_BEGIN { pg8::Gemm g{(const bf16_t*)(ws + OFF_A), (const bf16_t*)(ws + OFF_ATTNIN), DM, DM, DM}; pg8::Sched S; S.init(0, 68, 6, 1, 0, G, cidx);
               pg8::EpiQKV E{(bf16_t*)(ws + OFF_Q), (bf16_t*)(ws + OFF_K), (bf16_t*)(ws + OFF_V), (const float*)(ws + OFF_ROPE), RSQJ(4), BETAJ(4)}; pg8::gemm_phase(lds, g, S, E); } PH_END
    PH_BEGIN phase_attn(p, lds); PH_END
    PH_BEGIN { pg8::Gemm g{(const bf16_t*)(ws + OFF_O), (const bf16_t*)(ws + OFF_ATTNOUT), DM, DM, DM}; pg8::Sched S; S.init(1, 64, 4, 1, 0, G, cidx);
               pg8::EpiResid<false, true> E{p.out, XC, p.out, XC, mods1, 5, ABUF, GAMJ(5), RSQJ(5)}; pg8::gemm_phase(lds, g, S, E); } PH_END
    PH_BEGIN { pg8::Gemm g{(const bf16_t*)(ws + OFF_A), (const bf16_t*)(ws + OFF_W1T1 + SZ_W1T), DM, DM, DM}; pg8::Sched S; S.init(1, 64, 22, 1, 0, G, cidx);
               pg8::EpiSwiglu E{(bf16_t*)(ws + OFF_ACT), RSQJ(5), BETAJ(5)}; pg8::gemm_phase(lds, g, S, E); } PH_END
    PH_BEGIN { pg8::Gemm g{(const bf16_t*)(ws + OFF_ACT), (const bf16_t*)(ws + OFF_W2T1 + SZ_W2T), DFF, DFF, DFF}; pg8::Sched S; S.init(1, 64, 4, 1, 0, G, cidx);
               pg8::EpiResid<true, false> E{p.out, XC, p.out, XC, mods1, 8, ABUF, GAMJ(0), RSQJ(6)}; pg8::gemm_phase(lds, g, S, E); } PH_END
    PH_BEGIN phase_final(p); PH_END
}
constexpr int N_PHASES = 22;

extern "C" void kernel_launch(void* const* d_in, const int* in_sizes, int n_in, void* d_out, int out_size, void* d_ws, size_t ws_size, hipStream_t stream) {
    static int grid = 0;
    if (grid == 0) {
        if (n_in != 36 || ws_size < WS_NEED) { fprintf(stderr, "kernel_launch: need 36 inputs and %zu bytes of workspace (got %d, %zu)\n", (size_t)WS_NEED, n_in, ws_size); grid = -1; return; }
        int dev = 0, cus = 0;
        if (hipGetDevice(&dev) != hipSuccess || hipDeviceGetAttribute(&cus, hipDeviceAttributeMultiprocessorCount, dev) != hipSuccess) { grid = -1; return; }
        if (hipFuncSetAttribute((const void*)fwd_kernel, hipFuncAttributeMaxDynamicSharedMemorySize, LDS_BYTES) != hipSuccess) { fprintf(stderr, "kernel_launch: hipFuncSetAttribute failed\n"); grid = -1; return; }
        int per_cu = 0; (void)hipOccupancyMaxActiveBlocksPerMultiprocessor(&per_cu, (const void*)fwd_kernel, 512, LDS_BYTES); (void)hipGetLastError();
        grid = cus < 256 ? cus : 256;
    }
    if (grid < 0) return;
    (void)hipMemsetAsync((char*)d_ws + OFF_BAR, 0, OFF_XC, stream);
    Params p{};
    for (int i = 0; i < 36; ++i) p.in[i] = (const float*)d_in[i];
    p.out = (float*)d_out; p.ws = (unsigned char*)d_ws;
#if N_LAUNCH_MODE == 1
    p.ph_lo = 0; p.ph_hi = N_PHASES;
    hipLaunchKernelGGL(fwd_kernel, dim3(grid), dim3(512), LDS_BYTES, stream, p);
#else
    for (int i = 0; i < N_PHASES; ++i) { p.ph_lo = i; p.ph_hi = i + 1; hipLaunchKernelGGL(fwd_kernel, dim3(grid), dim3(512), LDS_BYTES, stream, p); }
#endif
}
```

```cpp
#include <hip/hip_runtime.h>
#include <stdint.h>
#include <cstdio>
#include <hip/amd_detail/amd_hip_unsafe_atomics.h>

#ifndef N_LAUNCH_MODE
#define N_LAUNCH_MODE 1
#endif

#ifndef REP_MASK
#define REP_MASK 0u
#endif
#define LAS __attribute__((address_space(3)))
typedef unsigned short bf16_t;
typedef short bf16x8 __attribute__((ext_vector_type(8)));
typedef short s16x4 __attribute__((ext_vector_type(4)));
typedef float f32x4 __attribute__((ext_vector_type(4)));
typedef float f32x2 __attribute__((ext_vector_type(2)));
typedef unsigned u32x4 __attribute__((ext_vector_type(4)));
typedef unsigned u32x2 __attribute__((ext_vector_type(2)));
typedef _Float16 h16;

constexpr int NB = 4, SEQ = 4096, LC = 256, LT = 4352, MR = 17408, DM = 1024, DFF = 2816;
constexpr int NCH = 136;
constexpr int NROWS_G = 544;
constexpr size_t SZ512 = (size_t)MR * 512 * 2;
constexpr size_t OFF_BAR = 0;
constexpr size_t OFF_LORA = 16384;
constexpr size_t OFF_ROWSQ = OFF_LORA + 1310720;
constexpr size_t OFF_XC = OFF_ROWSQ + 487424;
constexpr size_t OFF_MODS = OFF_XC + 4194304;
constexpr size_t OFF_ROPE = OFF_MODS + 368640;
constexpr size_t OFF_KTAB = OFF_ROPE + 1048576;
constexpr size_t SZ_W1T = 11534336, SZ_W2T = 5767168;
constexpr size_t OFF_W1T0 = OFF_KTAB + 2097152;
constexpr size_t OFF_W2T0 = OFF_W1T0 + 2 * SZ_W1T;
constexpr size_t OFF_ABIN = OFF_W2T0 + 2 * SZ_W2T;
constexpr size_t OFF_ABOUT = OFF_ABIN + 4718592;
constexpr size_t OFF_GLU = OFF_ABOUT + 2097152;
constexpr size_t OFF_KG = OFF_GLU + 524288;
constexpr size_t OFF_F = OFF_KG + 25165824;
constexpr size_t OFF_A = OFF_F + 8388608;
constexpr size_t OFF_ACT = OFF_A + 35651584;
constexpr size_t OFF_P = OFF_ACT;
constexpr size_t OFF_G = OFF_ACT + 80216064;
constexpr size_t OFF_Q = OFF_ACT;
constexpr size_t OFF_K = OFF_ACT + 35651584;
constexpr size_t OFF_V = OFF_K + 8912896;
constexpr size_t OFF_LW = OFF_ACT + 98041856;
constexpr size_t OFF_MIX = OFF_LW;
constexpr size_t OFF_LWA = OFF_P;
constexpr size_t OFF_CAT = OFF_P;
constexpr size_t OFF_W1T1 = OFF_LW;
constexpr size_t OFF_W2T1 = OFF_W1T1 + 2 * SZ_W1T;
constexpr size_t OFF_ATTNIN = OFF_W2T1 + 2 * SZ_W2T;
constexpr size_t OFF_ATTNOUT = OFF_ATTNIN + 3145728;
constexpr size_t OFF_ALORA = OFF_LW + 71303168;
constexpr size_t OFF_UX = OFF_ALORA + 8912896;
constexpr size_t OFF_E = OFF_UX + 26738688;
constexpr size_t OFF_GAM = OFF_E + 17825792;
constexpr size_t OFF_BETA = OFF_GAM + 143360;
constexpr size_t WS_NEED = OFF_BETA + 788480;
constexpr size_t OFF_O = OFF_ALORA;
constexpr int LDS_BYTES = 163840;
constexpr int MISC_OFF = 163840 - 256;

struct Params { const float* in[36]; float* out; unsigned char* ws; int ph_lo, ph_hi; };
#define PIN(i) (((const float* const volatile __attribute__((address_space(4)))*)__builtin_amdgcn_kernarg_segment_ptr())[(i)])

__device__ __forceinline__ bf16_t f2bf(float f) { unsigned u = __float_as_uint(f); u += 0x7fffu + ((u >> 16) & 1u); return (bf16_t)(u >> 16); }
__device__ __forceinline__ float bf2f(unsigned h) { return __uint_as_float(h << 16); }
__device__ __forceinline__ unsigned cvt_pk_bf16(float lo, float hi) { unsigned r; asm volatile("v_cvt_pk_bf16_f32 %0, %1, %2" : "=v"(r) : "v"(lo), "v"(hi)); return r; }
__device__ __forceinline__ unsigned pk_h16(float lo, float hi) { h16 a = (h16)lo, b = (h16)hi; return (unsigned)__builtin_bit_cast(unsigned short, a) | ((unsigned)__builtin_bit_cast(unsigned short, b) << 16); }
__device__ __forceinline__ float h2f(unsigned h) { return (float)__builtin_bit_cast(h16, (unsigned short)h); }
__device__ __forceinline__ float lo_bf(unsigned w) { return __uint_as_float(w << 16); }
__device__ __forceinline__ float hi_bf(unsigned w) { return __uint_as_float(w & 0xffff0000u); }
__device__ __forceinline__ float lo_h(unsigned w) { return h2f(w & 0xffffu); }
__device__ __forceinline__ float hi_h(unsigned w) { return h2f(w >> 16); }
__device__ __forceinline__ float sigmoidf_(float x) { return __builtin_amdgcn_rcpf(1.0f + __expf(-x)); }
__device__ __forceinline__ float siluf_(float x) { return x * sigmoidf_(x); }
__device__ __forceinline__ float wave_sum(float v) { for (int o = 32; o >= 1; o >>= 1) v += __shfl_xor(v, o); return v; }
template <int CTRL> __device__ __forceinline__ float dpp_mov(float x) { return __builtin_bit_cast(float, __builtin_amdgcn_update_dpp(0, __builtin_bit_cast(int, x), CTRL, 0xf, 0xf, false)); }
__device__ __forceinline__ float allreduce16(float x) { x += dpp_mov<0x128>(x); x += dpp_mov<0x124>(x); x += dpp_mov<0x122>(x); x += dpp_mov<0x121>(x); return x; }

__device__ __forceinline__ float fma_s(float a, float b, float c) { float d; asm("v_fma_f32 %0, %1, %2, %3" : "=v"(d) : "v"(a), "v"(b), "v"(c)); return d; }
__device__ __forceinline__ float fnma_s(float a, float b, float c) { float d; asm("v_fma_f32 %0, -%1, %2, %3" : "=v"(d) : "v"(a), "v"(b), "v"(c)); return d; }
__device__ __forceinline__ float mul_s(float a, float b) { float d; asm("v_mul_f32 %0, %1, %2" : "=v"(d) : "v"(a), "v"(b)); return d; }
__device__ __forceinline__ float mixlo(unsigned h, float x, float c) { float d; asm("v_fma_mix_f32 %0, %1, %2, %3 op_sel:[0,0,0] op_sel_hi:[1,0,0]" : "=v"(d) : "v"(h), "v"(x), "v"(c)); return d; }
__device__ __forceinline__ float mixhi(unsigned h, float x, float c) { float d; asm("v_fma_mix_f32 %0, %1, %2, %3 op_sel:[1,0,0] op_sel_hi:[1,0,0]" : "=v"(d) : "v"(h), "v"(x), "v"(c)); return d; }
#define LDS_BARRIER() do { asm volatile("s_waitcnt lgkmcnt(0)" ::: "memory"); __builtin_amdgcn_s_barrier(); asm volatile("" ::: "memory"); } while (0)
__device__ __forceinline__ int otid() { int t = threadIdx.x; asm volatile("" : "+v"(t)); return t; }
__device__ __forceinline__ const float* in_row(const Params& p, int b, int t) { return t < LC ? PIN(2) + ((size_t)b * LC + t) * DM : PIN(0) + ((size_t)b * SEQ + (t - LC)) * DM; }
__device__ __forceinline__ float* x_row(const Params& p, int b, int t) { return t < LC ? (float*)(p.ws + OFF_XC) + ((size_t)b * LC + t) * DM : p.out + ((size_t)b * SEQ + (t - LC)) * DM; }

#define XB_TMO      128
#define XB_XCNT(j)  (256  + 64 * (j))
#define XB_XSUB(j)  (1280 + 64 * (j))
#define XB_XGEN(j)  (2304 + 64 * (j))
#define XB_TOP      3328
#define XB_TOPGEN   3392
#define XCD_BAR_WORDS 3456
#define XB_SPIN_CAP (1u << 20)
__device__ __forceinline__ unsigned xb_ld(unsigned* p)              { return __hip_atomic_load(p, __ATOMIC_RELAXED, __HIP_MEMORY_SCOPE_AGENT); }
__device__ __forceinline__ unsigned xb_add(unsigned* p, unsigned v) { return __hip_atomic_fetch_add(p, v, __ATOMIC_RELAXED, __HIP_MEMORY_SCOPE_AGENT); }
__device__ __forceinline__ unsigned xb_xcc_id() { return (unsigned)__builtin_amdgcn_s_getreg((3 << 11) | 20) & 0xFu; }
#define XB_SPIN(cond, bar) do { unsigned _sp = 0; while (cond) { __builtin_amdgcn_s_sleep(1); \
    if ((++_sp & 255u) == 0u) { if (xb_ld(&(bar)[XB_TMO])) break; if (_sp > XB_SPIN_CAP) { atomicAdd(&(bar)[XB_TMO], 1u); break; } } } } while (0)
struct XcdBarrier { unsigned* bar; unsigned x; volatile LAS unsigned* st; };
__device__ __forceinline__ XcdBarrier xcd_barrier_post(unsigned* bar, volatile LAS unsigned* st) {
    XcdBarrier b; b.bar = bar; b.x = xb_xcc_id(); b.st = st;
    if (threadIdx.x == 0) (void)xb_add(&bar[XB_XCNT(b.x)], 1u);
    return b;
}
__device__ __forceinline__ void xcd_barrier_complete(unsigned* bar, unsigned x, unsigned& nloc, unsigned& nx) {
    const unsigned G = gridDim.x * gridDim.y * gridDim.z;
    unsigned sum, cnt, mine, sp = 0u;
    for (;;) {
        sum = 0u; cnt = 0u; mine = 0u;
#pragma unroll
        for (unsigned j = 0; j < 16; ++j) { const unsigned c = xb_ld(&bar[XB_XCNT(j)]); sum += c; cnt += (c > 0u) ? 1u : 0u; mine = (j == x) ? c : mine; }
        if (sum == G) break;
        __builtin_amdgcn_s_sleep(1);
        if ((++sp & 255u) == 0u) { if (xb_ld(&bar[XB_TMO])) break; if (sp > XB_SPIN_CAP) { atomicAdd(&bar[XB_TMO], 1u); break; } }
    }
    nloc = mine > 0u ? mine : 1u; nx = cnt > 0u ? cnt : 1u;
}
__device__ __forceinline__ void xcd_barrier(const XcdBarrier& b) {
    asm volatile("s_waitcnt vmcnt(0)" ::: "memory");
    __syncthreads();
    if (threadIdx.x == 0) {
        unsigned* bar = b.bar;
        __builtin_amdgcn_s_waitcnt(0);
        unsigned nloc = b.st[0], nx = b.st[1];
        if (nloc == 0u) { xcd_barrier_complete(bar, b.x, nloc, nx); b.st[0] = nloc; b.st[1] = nx; }
        const unsigned old = xb_add(&bar[XB_XSUB(b.x)], 1u);
        const unsigned gen = old / nloc;
        if (old + 1u == (gen + 1u) * nloc) {
            __builtin_amdgcn_fence(__ATOMIC_RELEASE, "agent");
            asm volatile("s_waitcnt vmcnt(0)" ::: "memory");
            const unsigned og = xb_add(&bar[XB_TOP], 1u);
            const unsigned tg = og / nx;
            if (og + 1u == (tg + 1u) * nx) xb_add(&bar[XB_TOPGEN], 1u);
            else XB_SPIN(xb_ld(&bar[XB_TOPGEN]) == tg, bar);
            __builtin_amdgcn_fence(__ATOMIC_ACQUIRE, "agent");
            xb_add(&bar[XB_XGEN(b.x)], 1u);
            asm volatile("s_waitcnt vmcnt(0)" ::: "memory");
        } else {
            XB_SPIN(xb_ld(&bar[XB_XGEN(b.x)]) == gen, bar);
            __builtin_amdgcn_fence(__ATOMIC_ACQUIRE, "agent");
            asm volatile("s_waitcnt vmcnt(0)" ::: "memory");
        }
    }
    __syncthreads();
}

namespace pg8 {
constexpr int BM = 256, BK = 64, HALF = 128, HTB = HALF * BK * 2, STAGE_BYTES = 8 * HTB, NXCD = 8, WGM = 8;
__device__ __forceinline__ int lds_byte(int r, int c) { const int st = (r >> 4) * 2 + (c >> 5), rr = r & 15, cc = c & 31, ob = rr * 64 + cc * 2; return st * 1024 + (ob ^ (((ob >> 9) & 1) << 5)); }
__device__ __forceinline__ void stage_rc(int b, int& R, int& C) { const int st = b / 1024, sb = b % 1024, swz = sb ^ (((sb >> 9) & 1) << 5); R = (st >> 1) * 16 + swz / 64; C = (st & 1) * 32 + (swz % 64) / 2; }
__device__ __forceinline__ int perm32(int rho) { const int n = rho >> 4, i = rho & 15; return 8 * (i >> 2) + 4 * n + (i & 3); }
struct Unit { int arow, brow, pm, pn, g; };
struct Gemm { const bf16_t* A; const bf16_t* Bt; int K, lda, ldb; };
struct Sched {
    int nM, nN, nwg, G, c, mode, browg;
    __device__ void init(int mode_, int nM_, int nN_, int ng, int browg_, int G_, int c_) { mode = mode_; nM = nM_; nN = nN_; nwg = nM_ * nN_ * ng; browg = browg_; G = G_; c = c_; }
    __device__ bool next(int i, Unit& u) const {
        const long L = (long)i * G + c; if (L >= nwg) return false;
        int wgid = (int)L;
        if (mode <= 1) {
            { const int q = nwg / NXCD, r = nwg % NXCD, xcd = wgid % NXCD, off = wgid / NXCD; wgid = (xcd < r ? xcd * (q + 1) : r * (q + 1) + (xcd - r) * q) + off; }
            const int nig = WGM * nN, gid = wgid / nig, fm = gid * WGM, gsz = (nM - fm) < WGM ? (nM - fm) : WGM;
            int pm = fm + ((wgid % nig) % gsz); const int pn = (wgid % nig) / gsz;
            if (mode == 1) pm = (pm >> 4) * 17 + 1 + (pm & 15);
            u.pm = pm; u.pn = pn; u.g = 0; u.arow = pm * BM; u.brow = pn * BM;
        } else {
            const int per = nM * nN, g = wgid / per, rem = wgid % per;
            u.g = g; u.pm = rem % nM; u.pn = rem / nM; u.arow = g * NROWS_G + u.pm * BM; u.brow = g * browg + u.pn * BM;
        }
        return true;
    }
};

template <class Epi>
__device__ __forceinline__ void gemm_phase(LAS unsigned char* lds, const Gemm g, const Sched& S, const Epi& E) {
    const int tid = otid(), wid = __builtin_amdgcn_readfirstlane(tid >> 6), lane = tid & 63, wr = wid >> 2, wc = wid & 3, fr = lane & 15, fq = lane >> 4;
    const int K = g.K, nt = K / BK;
    unsigned voffA[2], voffB[2];
#pragma unroll
    for (int i = 0; i < 2; ++i) { int R, C; stage_rc(tid * 16 + i * 8192, R, C); const int Rb = Epi::PERM ? ((R & ~31) + perm32(R & 31)) : R;
        voffA[i] = (unsigned)(R * g.lda + C) * 2u; voffB[i] = (unsigned)(Rb * g.ldb + C) * 2u; }
    const size_t kstep = (size_t)(BK * 2);
    const size_t hstepA = (size_t)HALF * g.lda * 2, hstepB = (size_t)HALF * g.ldb * 2;
    const unsigned ldsw = (unsigned)wid * 1024u;
    const int aoff = lds_byte(wr * 64 + fr, fq * 8), boff = lds_byte(wc * 32 + fr, fq * 8);
#define PG8_SA(b, h) (((b) * 2 + (h)) * HTB)
#define PG8_SB(b, h) ((4 + (b) * 2 + (h)) * HTB)
#define PG8_STAGE(bufoff, gbase, voff) do { _Pragma("unroll") for (int _i = 0; _i < 2; ++_i) \
        __builtin_amdgcn_global_load_lds((const unsigned*)((const char*)(gbase) + (voff)[_i]), (LAS unsigned*)(lds + (bufoff) + ldsw + _i * 8192), 16, 0, 0); } while (0)
#define PG8_LDA(dst, b, h) do { _Pragma("unroll") for (int m = 0; m < 4; ++m) _Pragma("unroll") for (int k = 0; k < 2; ++k) dst[m][k] = *(const LAS bf16x8*)(lds + PG8_SA(b, h) + aoff + m * 2048 + k * 1024); } while (0)
#define PG8_LDB(dst, b, h) do { _Pragma("unroll") for (int n = 0; n < 2; ++n) _Pragma("unroll") for (int k = 0; k < 2; ++k) dst[n][k] = *(const LAS bf16x8*)(lds + PG8_SB(b, h) + boff + n * 2048 + k * 1024); } while (0)
#define PG8_MMA(ai, bj, At, Bt) do { __builtin_amdgcn_s_setprio(1); _Pragma("unroll") for (int m = 0; m < 4; ++m) _Pragma("unroll") for (int n = 0; n < 2; ++n) _Pragma("unroll") for (int k = 0; k < 2; ++k) \
        acc[ai][bj][m][n] = __builtin_amdgcn_mfma_f32_16x16x32_bf16(Bt[n][k], At[m][k], acc[ai][bj][m][n], 0, 0, 0); __builtin_amdgcn_s_setprio(0); } while (0)
#define PG8_WAIT_V(n) asm volatile("s_waitcnt vmcnt(" #n ")" ::: "memory")
#define PG8_WAIT_L(n) asm volatile("s_waitcnt lgkmcnt(" #n ")" ::: "memory")
#define PG8_BAR __builtin_amdgcn_s_barrier()
#define PG8_SCHED __builtin_amdgcn_sched_barrier(0)
    Unit cur, nxt; int ui = 0;
    if (!S.next(0, cur)) return;
    f32x4 acc[2][2][4][2];
#pragma unroll
    for (int a = 0; a < 2; ++a)
#pragma unroll
        for (int b = 0; b < 2; ++b)
#pragma unroll
            for (int m = 0; m < 4; ++m)
#pragma unroll
                for (int n = 0; n < 2; ++n) acc[a][b][m][n] = (f32x4){0.f, 0.f, 0.f, 0.f};
    bf16x8 At[4][2], B0[2][2], B1[2][2];
    const char* cA = (const char*)g.A + (size_t)cur.arow * g.lda * 2; const char* cB = (const char*)g.Bt + (size_t)cur.brow * g.ldb * 2;
    PG8_STAGE(PG8_SB(0, 0), cB, voffB); PG8_STAGE(PG8_SA(0, 0), cA, voffA); PG8_STAGE(PG8_SB(0, 1), cB + hstepB, voffB); PG8_STAGE(PG8_SA(0, 1), cA + hstepA, voffA);
    if (wr == 1) PG8_BAR;
    PG8_WAIT_V(4); PG8_BAR;
    PG8_STAGE(PG8_SB(1, 0), cB + kstep, voffB); PG8_STAGE(PG8_SA(1, 0), cA + kstep, voffA); PG8_STAGE(PG8_SB(1, 1), cB + hstepB + kstep, voffB);
    PG8_WAIT_V(6); PG8_BAR;
    for (;;) {
        const bool has_next = S.next(ui + 1, nxt);
        const char* nA = has_next ? (const char*)g.A + (size_t)nxt.arow * g.lda * 2 : cA; const char* nB = has_next ? (const char*)g.Bt + (size_t)nxt.brow * g.ldb * 2 : cB;
        for (int t = 0; t < nt; t += 2) {
            const bool last = (t == nt - 2);
            const char* a1 = cA + (size_t)(t + 1) * kstep;
            const char* a2 = last ? nA : cA + (size_t)(t + 2) * kstep; const char* b2 = last ? nB : cB + (size_t)(t + 2) * kstep;
            const char* a3 = a2 + kstep; const char* b3 = b2 + kstep;
            PG8_LDB(B0, 0, 0); PG8_SCHED; PG8_LDA(At, 0, 0); PG8_STAGE(PG8_SA(1, 1), a1 + hstepA, voffA);
            PG8_WAIT_L(8); PG8_BAR; PG8_WAIT_L(0); PG8_MMA(0, 0, At, B0); PG8_BAR; PG8_SCHED;
            PG8_LDB(B1, 0, 1); PG8_STAGE(PG8_SB(0, 0), b2, voffB);
            PG8_BAR; PG8_WAIT_L(0); PG8_MMA(0, 1, At, B1); PG8_BAR;
            PG8_LDA(At, 0, 1); PG8_STAGE(PG8_SA(0, 0), a2, voffA);
            PG8_BAR; PG8_WAIT_L(0); PG8_MMA(1, 0, At, B0); PG8_BAR; PG8_SCHED;
            PG8_STAGE(PG8_SB(0, 1), b2 + hstepB, voffB);
            PG8_WAIT_V(6); PG8_BAR; PG8_MMA(1, 1, At, B1); PG8_BAR;
            PG8_LDB(B0, 1, 0); PG8_SCHED; PG8_LDA(At, 1, 0); PG8_STAGE(PG8_SA(0, 1), a2 + hstepA, voffA);
            PG8_WAIT_L(8); PG8_BAR; PG8_WAIT_L(0); PG8_MMA(0, 0, At, B0); PG8_BAR; PG8_SCHED;
            PG8_LDB(B1, 1, 1); PG8_STAGE(PG8_SB(1, 0), b3, voffB);
            PG8_BAR; PG8_WAIT_L(0); PG8_MMA(0, 1, At, B1); PG8_BAR;
            PG8_LDA(At, 1, 1); PG8_STAGE(PG8_SA(1, 0), a3, voffA);
            PG8_BAR; PG8_WAIT_L(0); PG8_MMA(1, 0, At, B0); PG8_BAR; PG8_SCHED;
            PG8_STAGE(PG8_SB(1, 1), b3 + hstepB, voffB);
            PG8_WAIT_V(6); PG8_BAR; PG8_MMA(1, 1, At, B1); PG8_BAR;
        }
        E(acc, cur, wr, wc, fr, fq);
        if (!has_next) break;
#pragma unroll
        for (int a = 0; a < 2; ++a)
#pragma unroll
            for (int b = 0; b < 2; ++b)
#pragma unroll
                for (int m = 0; m < 4; ++m)
#pragma unroll
                    for (int n = 0; n < 2; ++n) acc[a][b][m][n] = (f32x4){0.f, 0.f, 0.f, 0.f};
        cur = nxt; cA = nA; cB = nB; ++ui;
    }
    PG8_WAIT_V(0);
    if (wr == 0) PG8_BAR;
    PG8_BAR;
#undef PG8_SA
#undef PG8_SB
#undef PG8_STAGE
#undef PG8_LDA
#undef PG8_LDB
#undef PG8_MMA
#undef PG8_WAIT_V
#undef PG8_WAIT_L
#undef PG8_BAR
#undef PG8_SCHED
}

typedef f32x4 AccT[2][2][4][2];

struct EpiSwiglu {
    static constexpr bool PERM = true; bf16_t* O; const float* rowsq; const float* beta;
    __device__ __forceinline__ void operator()(const AccT& acc, const Unit& u, int wr, int wc, int fr, int fq) const {
        const int b = u.pm / 17, pt = u.pm % 17;
        const float* bt = beta + (size_t)(pt == 0 ? 4 : b) * 5632 + u.pn * BM + wc * 32 + 8 * fq;
        const f32x4 bg0 = *(const f32x4*)bt, bg1 = *(const f32x4*)(bt + 4), bu0 = *(const f32x4*)(bt + HALF), bu1 = *(const f32x4*)(bt + HALF + 4);
        float rsv[2][4];
#pragma unroll
        for (int ai = 0; ai < 2; ++ai)
#pragma unroll
            for (int m = 0; m < 4; ++m) rsv[ai][m] = rowsq[(size_t)u.pm * BM + ai * HALF + wr * 64 + m * 16 + fr];
#pragma unroll
        for (int ai = 0; ai < 2; ++ai)
#pragma unroll
            for (int m = 0; m < 4; ++m) {
                const size_t row = (size_t)u.pm * BM + ai * HALF + wr * 64 + m * 16 + fr;
                const float rs = rsqrtf(rsv[ai][m] * (1.0f / 1024.0f) + 1e-6f);
                const f32x4 g0 = acc[ai][0][m][0] * rs + bg0, g1 = acc[ai][0][m][1] * rs + bg1, u0 = acc[ai][1][m][0] * rs + bu0, u1 = acc[ai][1][m][1] * rs + bu1;
                u32x4 w; w.x = cvt_pk_bf16(siluf_(g0[0]) * u0[0], siluf_(g0[1]) * u0[1]); w.y = cvt_pk_bf16(siluf_(g0[2]) * u0[2], siluf_(g0[3]) * u0[3]);
                w.z = cvt_pk_bf16(siluf_(g1[0]) * u1[0], siluf_(g1[1]) * u1[1]); w.w = cvt_pk_bf16(siluf_(g1[2]) * u1[2], siluf_(g1[3]) * u1[3]);
                *(u32x4*)(O + row * DFF + u.pn * 128 + wc * 32 + 8 * fq) = w;
            }
    }
};
template <bool HALFG, bool FUSE> struct EpiResid {
    static constexpr bool PERM = false;
    const float* src_lat; const float* src_ctx; float* dst_lat; float* dst_ctx; const float* mods_l; int gate_chunk;
    bf16_t* An; const float* gam; float* rowsq;
    __device__ __forceinline__ void operator()(const AccT& acc, const Unit& u, int wr, int wc, int fr, int fq) const {
        const int b = u.pm / 17, pt = u.pm % 17, mv = pt == 0 ? 4 : b;
        const float* gate = mods_l + (size_t)mv * 9216 + gate_chunk * 1024;
        const int col0 = u.pn * BM + wc * 32 + 4 * fq;
        f32x4 gv[2][2];
#pragma unroll
        for (int bj = 0; bj < 2; ++bj)
#pragma unroll
            for (int n = 0; n < 2; ++n) gv[bj][n] = *(const f32x4*)(gate + col0 + bj * HALF + n * 16) * (HALFG ? 0.5f : 1.0f);
        const float* gm = gam + (size_t)mv * 1024 + col0;
        f32x4 gmv[2][2];
#pragma unroll
        for (int bj = 0; bj < 2; ++bj)
#pragma unroll
            for (int n = 0; n < 2; ++n) gmv[bj][n] = FUSE ? *(const f32x4*)(gm + bj * HALF + n * 16) : (f32x4){0.f, 0.f, 0.f, 0.f};
        const float* sbase = (pt == 0 ? src_ctx : src_lat) + ((pt == 0) ? ((size_t)b * LC) * DM : ((size_t)b * SEQ + (pt - 1) * 256) * DM) + col0;
        float* dbase = (pt == 0 ? dst_ctx : dst_lat) + ((pt == 0) ? ((size_t)b * LC) * DM : ((size_t)b * SEQ + (pt - 1) * 256) * DM) + col0;
        f32x4 sv[2][2];
        { const float* sp = sbase + (size_t)(wr * 64 + fr) * DM;
#pragma unroll
          for (int bj = 0; bj < 2; ++bj)
#pragma unroll
              for (int n = 0; n < 2; ++n) sv[bj][n] = *(const f32x4*)(sp + bj * HALF + n * 16); }
#pragma unroll
        for (int idx = 0; idx < 8; ++idx) {
            const int ai = idx >> 2, m = idx & 3;
            const int rl = ai * HALF + wr * 64 + m * 16 + fr;
            f32x4 nx[2][2];
            if (idx + 1 < 8) { const int rl2 = ((idx + 1) >> 2) * HALF + wr * 64 + ((idx + 1) & 3) * 16 + fr; const float* sp = sbase + (size_t)rl2 * DM;
#pragma unroll
                for (int bj = 0; bj < 2; ++bj)
#pragma unroll
                    for (int n = 0; n < 2; ++n) nx[bj][n] = *(const f32x4*)(sp + bj * HALF + n * 16); }
            float* dp = dbase + (size_t)rl * DM;
            const size_t row = (size_t)u.pm * BM + rl;
            float ss = 0.f;
#pragma unroll
            for (int bj = 0; bj < 2; ++bj)
#pragma unroll
                for (int n = 0; n < 2; ++n) { const f32x4 xn = sv[bj][n] + gv[bj][n] * acc[ai][bj][m][n]; *(f32x4*)(dp + bj * HALF + n * 16) = xn;
                    if (FUSE) { ss += xn[0] * xn[0] + xn[1] * xn[1] + xn[2] * xn[2] + xn[3] * xn[3];
                        const f32x4 a = xn * gmv[bj][n]; u32x2 w; w.x = cvt_pk_bf16(a[0], a[1]); w.y = cvt_pk_bf16(a[2], a[3]);
                        *(u32x2*)(An + row * DM + col0 + bj * HALF + n * 16) = w; } }
            if (FUSE) { ss += __shfl_xor(ss, 16); ss += __shfl_xor(ss, 32); if (fq == 0) unsafeAtomicAdd(rowsq + row, ss); }
            if (idx + 1 < 8) {
#pragma unroll
                for (int bj = 0; bj < 2; ++bj)
#pragma unroll
                    for (int n = 0; n < 2; ++n) sv[bj][n] = nx[bj][n]; }
        }
    }
};
struct EpiStoreBf16 {
    static constexpr bool PERM = true; bf16_t* O; int ldc; const float* rowsq; const float* beta; int nbeta;
    __device__ __forceinline__ void operator()(const AccT& acc, const Unit& u, int wr, int wc, int fr, int fq) const {
        const int b = u.pm / 17, pt = u.pm % 17;
        const float* bt = beta + (size_t)(pt == 0 ? 4 : b) * nbeta + u.pn * BM + wc * 32 + 8 * fq;
        float rsv[2][4];
#pragma unroll
        for (int ai = 0; ai < 2; ++ai)
#pragma unroll
            for (int m = 0; m < 4; ++m) rsv[ai][m] = rsqrtf(rowsq[(size_t)u.pm * BM + ai * HALF + wr * 64 + m * 16 + fr] * (1.0f / 1024.0f) + 1e-6f);
#pragma unroll
        for (int bj = 0; bj < 2; ++bj) {
            const f32x4 b0 = *(const f32x4*)(bt + bj * HALF), b1 = *(const f32x4*)(bt + bj * HALF + 4);
#pragma unroll
            for (int ai = 0; ai < 2; ++ai)
#pragma unroll
                for (int m = 0; m < 4; ++m) {
                    const size_t row = (size_t)u.pm * BM + ai * HALF + wr * 64 + m * 16 + fr;
                    const float rs = rsv[ai][m];
                    const f32x4 v0 = acc[ai][bj][m][0] * rs + b0, v1 = acc[ai][bj][m][1] * rs + b1;
                    u32x4 w; w.x = cvt_pk_bf16(v0[0], v0[1]); w.y = cvt_pk_bf16(v0[2], v0[3]); w.z = cvt_pk_bf16(v1[0], v1[1]); w.w = cvt_pk_bf16(v1[2], v1[3]);
                    *(u32x4*)(O + row * ldc + u.pn * BM + bj * HALF + wc * 32 + 8 * fq) = w; }
        }
    }
};
struct EpiLora {
    static constexpr bool PERM = true; unsigned char* ws; const float* w0; const float* a0;
    __device__ __forceinline__ void operator()(const AccT& acc, const Unit& u, int wr, int wc, int fr, int fq) const {
        const int grp = u.pn >> 1;
        unsigned short* O = (unsigned short*)(grp < 4 ? ws + OFF_LWA + (size_t)grp * SZ512 : ws + OFF_G);
        const float* bias = grp < 2 ? w0 + grp * 512 : (grp < 4 ? a0 + (grp - 2) * 512 : nullptr);
#pragma unroll
        for (int bj = 0; bj < 2; ++bj)
#pragma unroll
            for (int n = 0; n < 2; ++n) {
                const int cc = (u.pn & 1) * 256 + bj * HALF + wc * 32 + 8 * fq + 4 * n;
                f32x4 bv = {0.f, 0.f, 0.f, 0.f}; if (bias) bv = *(const f32x4*)(bias + cc);
#pragma unroll
                for (int ai = 0; ai < 2; ++ai)
#pragma unroll
                    for (int m = 0; m < 4; ++m) {
                        const size_t row = (size_t)u.pm * BM + ai * HALF + wr * 64 + m * 16 + fr;
                        const f32x4 z4 = acc[ai][bj][m][n] + bv; float v[4];
#pragma unroll
                        for (int e = 0; e < 4; ++e) { const float z = z4[e];
                            if (grp < 2) v[e] = -0.60653066f * sigmoidf_(z);
                            else if (grp < 4) v[e] = sigmoidf_(z);
                            else v[e] = z; }
                        u32x2 w; w.x = pk_h16(v[0], v[1]); w.y = pk_h16(v[2], v[3]);
                        *(u32x2*)(O + row * 512 + cc) = w;
                    }
            }
    }
};
struct EpiE {
    static constexpr bool PERM = false; float* E;
    __device__ __forceinline__ void operator()(const AccT& acc, const Unit& u, int wr, int wc, int fr, int fq) const {
#pragma unroll
        for (int ai = 0; ai < 2; ++ai)
#pragma unroll
            for (int m = 0; m < 4; ++m) {
                const int n = u.pm * BM + ai * HALF + wr * 64 + m * 16 + fr;
                if (n < NROWS_G) { float* rp = E + ((size_t)u.g * NROWS_G + n) * 256 + wc * 32 + 4 * fq;
#pragma unroll
                    for (int bj = 0; bj < 2; ++bj)
#pragma unroll
                        for (int nn = 0; nn < 2; ++nn) *(f32x4*)(rp + bj * HALF + nn * 16) = acc[ai][bj][m][nn]; }
            }
    }
};
__device__ __forceinline__ float gelu_tanh(float y) { const float t = 0.7978845608f * (y + 0.044715f * y * y * y); const float e = __expf(2.0f * t); const float th = 1.0f - 2.0f * __builtin_amdgcn_rcpf(e + 1.0f); return 0.5f * y * (1.0f + th); }
struct EpiY {
    static constexpr bool PERM = false; const bf16_t* UX; const float* dsk; bf16_t* Z;
    __device__ __forceinline__ void operator()(const AccT& acc, const Unit& u, int wr, int wc, int fr, int fq) const {
        const int ch = u.g * 16 + 4 * fq;
        const f32x4 dv = *(const f32x4*)(dsk + ch);
#pragma unroll
        for (int ai = 0; ai < 2; ++ai)
#pragma unroll
            for (int m = 0; m < 4; ++m) {
                const int n = u.pm * BM + ai * HALF + wr * 64 + m * 16 + fr;
                if (n < NROWS_G) { const int b = n / NCH, c = n % NCH;
#pragma unroll
                    for (int bj = 0; bj < 2; ++bj)
#pragma unroll
                        for (int nn = 0; nn < 2; ++nn) {
                            const int mm = u.pn * BM + bj * HALF + wc * 32 + nn * 16 + 4 * fq;
                            const u32x2 uw = *(const u32x2*)(UX + ((size_t)u.g * NROWS_G + n) * 768 + mm);
                            const f32x4 a = acc[ai][bj][m][nn];
                            const float y0 = a[0] + dv[0] * lo_bf(uw.x), y1 = a[1] + dv[1] * hi_bf(uw.x), y2 = a[2] + dv[2] * lo_bf(uw.y), y3 = a[3] + dv[3] * hi_bf(uw.y);
                            u32x2 w; w.x = cvt_pk_bf16(gelu_tanh(y0), gelu_tanh(y1)); w.y = cvt_pk_bf16(gelu_tanh(y2), gelu_tanh(y3));
                            const size_t tok = (size_t)b * LT + c * 32 + (mm >> 4);
                            *(u32x2*)(Z + tok * 512 + ch) = w;
                        } }
            }
    }
};
struct EpiGlu {
    static constexpr bool PERM = true; const bf16_t* Z; const float* gb; bf16_t* CAT;
    __device__ __forceinline__ void operator()(const AccT& acc, const Unit& u, int wr, int wc, int fr, int fq) const {
#pragma unroll
        for (int bj = 0; bj < 2; ++bj) {
            const int cc = u.pn * BM + bj * HALF + wc * 32 + 8 * fq;
            const f32x4 b0 = *(const f32x4*)(gb + cc), b1 = *(const f32x4*)(gb + cc + 4);
#pragma unroll
            for (int ai = 0; ai < 2; ++ai)
#pragma unroll
                for (int m = 0; m < 4; ++m) {
                    const size_t row = (size_t)u.pm * BM + ai * HALF + wr * 64 + m * 16 + fr;
                    const u32x4 zw = *(const u32x4*)(Z + row * 512 + cc);
                    const f32x4 v0 = acc[ai][bj][m][0] + b0, v1 = acc[ai][bj][m][1] + b1;
                    u32x4 w; w.x = cvt_pk_bf16(lo_bf(zw.x) * sigmoidf_(v0[0]), hi_bf(zw.x) * sigmoidf_(v0[1])); w.y = cvt_pk_bf16(lo_bf(zw.y) * sigmoidf_(v0[2]), hi_bf(zw.y) * sigmoidf_(v0[3]));
                    w.z = cvt_pk_bf16(lo_bf(zw.z) * sigmoidf_(v1[0]), hi_bf(zw.z) * sigmoidf_(v1[1])); w.w = cvt_pk_bf16(lo_bf(zw.w) * sigmoidf_(v1[2]), hi_bf(zw.w) * sigmoidf_(v1[3]));
                    *(u32x4*)(CAT + row * DM + 512 + cc) = w;
                }
        }
    }
};
struct EpiQKV {
    static constexpr bool PERM = true; bf16_t* Q; bf16_t* Kb; bf16_t* Vb; const float* rope; const float* rowsq; const float* beta;
    __device__ __forceinline__ void operator()(const AccT& acc, const Unit& u, int wr, int wc, int fr, int fq) const {
        const int b = u.pm / 17, pt = u.pm % 17; const bool isctx = pt == 0;
        if (u.pn < 4 && isctx) return;
        const float* bt = beta + (size_t)(isctx ? 4 : b) * 1536 + u.pn * BM + wc * 32 + 8 * fq;
        float be1[8], be2[8];
#pragma unroll
        for (int e = 0; e < 8; ++e) { be1[e] = bt[e]; be2[e] = bt[HALF + e]; }
        float rsv[2][4];
#pragma unroll
        for (int ai = 0; ai < 2; ++ai)
#pragma unroll
            for (int m = 0; m < 4; ++m) rsv[ai][m] = rsqrtf(rowsq[(size_t)u.pm * BM + ai * HALF + wr * 64 + m * 16 + fr] * (1.0f / 1024.0f) + 1e-6f);
#pragma unroll
        for (int ai = 0; ai < 2; ++ai)
#pragma unroll
            for (int m = 0; m < 4; ++m) {
                const int rl = ai * HALF + wr * 64 + m * 16 + fr;
                const size_t row = (size_t)u.pm * BM + rl;
                float x1[8], x2[8];
                const float rs = rsv[ai][m];
#pragma unroll
                for (int e = 0; e < 8; ++e) { x1[e] = acc[ai][0][m][e >> 2][e & 3] * rs + be1[e]; x2[e] = acc[ai][1][m][e >> 2][e & 3] * rs + be2[e]; }
                if (u.pn < 5 && !isctx) {
                    const float* rp = rope + ((size_t)((pt - 1) * 256 + rl) * 32 + 8 * fq) * 2;
                    const float sc = u.pn < 4 ? 0.125f : 1.0f;
#pragma unroll
                    for (int e2 = 0; e2 < 4; ++e2) { const f32x4 cs = *(const f32x4*)(rp + e2 * 4);
                        { const float a = x1[2 * e2], bb = x2[2 * e2]; x1[2 * e2] = (a * cs[0] - bb * cs[1]) * sc; x2[2 * e2] = (bb * cs[0] + a * cs[1]) * sc; }
                        { const float a = x1[2 * e2 + 1], bb = x2[2 * e2 + 1]; x1[2 * e2 + 1] = (a * cs[2] - bb * cs[3]) * sc; x2[2 * e2 + 1] = (bb * cs[2] + a * cs[3]) * sc; } }
                }
                u32x4 w1, w2; w1.x = cvt_pk_bf16(x1[0], x1[1]); w1.y = cvt_pk_bf16(x1[2], x1[3]); w1.z = cvt_pk_bf16(x1[4], x1[5]); w1.w = cvt_pk_bf16(x1[6], x1[7]);
                w2.x = cvt_pk_bf16(x2[0], x2[1]); w2.y = cvt_pk_bf16(x2[2], x2[3]); w2.z = cvt_pk_bf16(x2[4], x2[5]); w2.w = cvt_pk_bf16(x2[6], x2[7]);
                bf16_t* op; if (u.pn < 4) op = Q + row * DM + (u.pn * 4 + wc) * 64; else { op = Kb + (u.pn == 4 ? (size_t)0 : (size_t)(OFF_V - OFF_K) / 2) + row * 256 + wc * 64; }
                *(u32x4*)(op + 8 * fq) = w1; *(u32x4*)(op + 32 + 8 * fq) = w2;
            }
    }
};
}

__device__ __forceinline__ int next_ticket(unsigned* ctr, volatile LAS unsigned* slot) {
    __syncthreads();
    if (threadIdx.x == 0) *slot = __hip_atomic_fetch_add(ctr, 1u, __ATOMIC_RELAXED, __HIP_MEMORY_SCOPE_AGENT);
    __syncthreads();
    return (int)*slot;
}
template <int MAP> __device__ __forceinline__ int colmap(int n) {
    if (MAP == 1) { const int pn = n >> 8, bj = (n >> 7) & 1, x = n & 127; return bj * DFF + pn * 128 + x; }
    if (MAP == 2) { const int pn = n >> 8, half = (n >> 7) & 1, hl = (n >> 5) & 3, rest = n & 31; return pn * 256 + hl * 64 + half * 32 + rest; }
    return n;
}
template <int MAP> __device__ __forceinline__ void convert_T(const float* src, int K, int N, int nrows, bf16_t* dst, int ldd, LAS float* tile, int& tbase, int vb, int vg) {
    const int tid = otid(), nkt = K / 64, ntiles = nkt * (nrows / 64);
    int first = vb - (tbase % vg); if (first < 0) first += vg;
    for (int tl = first; tl < ntiles; tl += vg) {
        const int n0 = (tl / nkt) * 64, k0 = (tl % nkt) * 64;
        __syncthreads();
#pragma unroll
        for (int e = 0; e < 8; ++e) { const int idx = e * 512 + tid, kk = idx >> 6, nn = idx & 63; tile[kk * 65 + nn] = src[(size_t)(k0 + kk) * N + colmap<MAP>(n0 + nn)]; }
        __syncthreads();
#pragma unroll
        for (int e = 0; e < 4; ++e) { const int idx = e * 512 + tid, nn = idx >> 5, kp = idx & 31;
            *(unsigned*)(dst + (size_t)(n0 + nn) * ldd + k0 + 2 * kp) = cvt_pk_bf16(tile[(2 * kp) * 65 + nn], tile[(2 * kp + 1) * 65 + nn]); }
    }
    tbase += ntiles;
}

__device__ __forceinline__ void p0_mods(const Params& p, LAS float* sl) {
    const int tid = otid();
    for (int i = tid; i < 5 * 1024; i += 512) { const int v = i >> 10, k = i & 1023; const float x = v < 4 ? PIN(1)[v * 1024 + k] : PIN(3)[k]; sl[i] = x / (1.0f + __expf(-x)); }
    LAS float* red = sl + 5 * 1024;
    float* mods = (float*)(p.ws + OFF_MODS);
    for (int chunk = blockIdx.x; chunk < 288; chunk += gridDim.x) {
        const int l = chunk / 144, col = (chunk % 144) * 64 + (tid & 63), kg = tid >> 6;
        const float* w = PIN(5) + (size_t)l * 1024 * 9216 + col;
        float a[5] = {0.f, 0.f, 0.f, 0.f, 0.f};
        __syncthreads();
        for (int k0 = kg * 128; k0 < kg * 128 + 128; k0 += 16) { float wv[16];
#pragma unroll
            for (int q = 0; q < 16; ++q) wv[q] = w[(size_t)(k0 + q) * 9216];
#pragma unroll
            for (int q = 0; q < 16; ++q)
#pragma unroll
                for (int v = 0; v < 5; ++v) a[v] += sl[v * 1024 + k0 + q] * wv[q]; }
#pragma unroll
        for (int v = 0; v < 5; ++v) red[(kg * 64 + (tid & 63)) * 5 + v] = a[v];
        __syncthreads();
        if (tid < 320) { const int v = tid / 64, cl = tid & 63; float s = 0.f;
#pragma unroll
            for (int q = 0; q < 8; ++q) s += red[(q * 64 + cl) * 5 + v];
            const int n = (chunk % 144) * 64 + cl;
            mods[((size_t)l * 5 + v) * 9216 + n] = s + PIN(6)[l * 9216 + n]; }
    }
    __syncthreads();
}

__device__ __forceinline__ void p0_rope(const Params& p) {
    float* rope = (float*)(p.ws + OFF_ROPE);
    for (int i = blockIdx.x * 512 + otid(); i < SEQ * 32; i += gridDim.x * 512) {
        const int t = i >> 5, j = i & 31;
        const float inv = powf(10000.0f, -(float)(j & 15) / 16.0f);
        const float pos = (float)(j < 16 ? (t >> 6) : (t & 63));
        const float ang = pos * inv; float s, c; sincosf(ang, &s, &c);
        rope[2 * i] = c; rope[2 * i + 1] = s;
    }
}

__device__ __forceinline__ void p0_s5ops(const Params& p, LAS float* sl) {
    const int tid = otid();
    LAS float* bbr = sl;
    LAS float* bbi = sl + 1024;
    LAS float* pwr = sl + 2048;
    LAS float* pwi = sl + 2112;
    LAS float* xs  = sl + 2176;
    LAS float* ths = sl + 2240;
    LAS float* cr  = sl + 2304;
    LAS float* ci  = sl + 3328;
    LAS float* red = sl + 4352;
    float* ktab = (float*)(p.ws + OFF_KTAB);
    bf16_t* KG = (bf16_t*)(p.ws + OFF_KG); bf16_t* Fm = (bf16_t*)(p.ws + OFF_F);
    for (int item4 = blockIdx.x; item4 < 256; item4 += gridDim.x) {
        const int item = item4 >> 2, tq = item4 & 3, tau_lo = tq == 0 ? 0 : tq * 8 + 1, tau_hi = tq * 8 + 8;
        const int g = item >> 1, d = item & 1, gd = d * 32 + g;
        __syncthreads();
        if (tid < 64) {
            const float lre = fminf(PIN(22)[gd * 64 + tid], -1e-4f), lim = PIN(23)[gd * 64 + tid], dt = __expf(PIN(24)[gd]);
            xs[tid] = lre * dt; ths[tid] = lim * dt;
        }
        for (int i = tid; i < 1024; i += 512) { cr[i] = PIN(27)[(size_t)gd * 1024 + i]; ci[i] = PIN(28)[(size_t)gd * 1024 + i]; }
        __syncthreads();
        for (int i = tid; i < 1024; i += 512) {
            const int pp = i >> 4;
            const float lre = fminf(PIN(22)[gd * 64 + pp], -1e-4f), lim = PIN(23)[gd * 64 + pp];
            const float x = xs[pp], th = ths[pp];
            float sn, cs; sincosf(th, &sn, &cs); const float mag = __expf(x);
            float sh, chh; sincosf(0.5f * th, &sh, &chh);
            const float am1r = expm1f(x) * cs - 2.0f * sh * sh, abi = mag * sn;
            const float den = lre * lre + lim * lim;
            const float fre = (am1r * lre + abi * lim) / den, fim = (abi * lre - am1r * lim) / den;
            const float br = PIN(25)[(size_t)gd * 1024 + i], bi = PIN(26)[(size_t)gd * 1024 + i];
            bbr[i] = fre * br - fim * bi; bbi[i] = fre * bi + fim * br;
        }
        for (int tau = tau_lo; tau <= tau_hi; ++tau) {
            __syncthreads();
            if (tid < 64) { const float mg = __expf((float)tau * xs[tid]); float sn, cs; sincosf((float)tau * ths[tid], &sn, &cs); pwr[tid] = mg * cs; pwi[tid] = mg * sn; }
            __syncthreads();
            if (tau < 32) {
                const int ij = tid & 255, i = ij >> 4, j = ij & 15, ph = tid >> 8; float s = 0.f;
                for (int pp = ph * 32; pp < ph * 32 + 32; ++pp) { const float qr = pwr[pp] * bbr[pp * 16 + j] - pwi[pp] * bbi[pp * 16 + j], qi = pwr[pp] * bbi[pp * 16 + j] + pwi[pp] * bbr[pp * 16 + j];
                    s += cr[i * 64 + pp] * qr - ci[i * 64 + pp] * qi; }
                red[tid] = s;
                const int sidx = d == 0 ? 31 - tau : tau;
                for (int q = tid; q < 1024; q += 512) { const int pp = q >> 4, jj = q & 15;
                    const float qr = pwr[pp] * bbr[q] - pwi[pp] * bbi[q], qi = pwr[pp] * bbi[q] + pwi[pp] * bbr[q];
                    bf16_t* fp = Fm + ((size_t)g * 256 + d * 128 + 2 * pp) * 512 + sidx * 16 + jj;
                    fp[0] = f2bf(qr); fp[512] = f2bf(qi); }
            }
            if (tau >= 1) {
                const int t = d == 0 ? tau - 1 : 32 - tau;
                for (int q = tid; q < 1024; q += 512) { const int i = q >> 6, pp = q & 63;
                    const float vr = cr[i * 64 + pp] * pwr[pp] - ci[i * 64 + pp] * pwi[pp], vi = cr[i * 64 + pp] * pwi[pp] + ci[i * 64 + pp] * pwr[pp];
                    *(unsigned*)(KG + ((size_t)g * 512 + t * 16 + i) * 768 + 512 + d * 128 + 2 * pp) = cvt_pk_bf16(vr, -vi); }
            }
            __syncthreads();
            if (tau < 32 && tid < 256) ktab[(((size_t)g * 2 + d) * 32 + tau) * 256 + tid] = red[tid] + red[tid + 256];
        }
    }
    __syncthreads();
}

__device__ __forceinline__ void p1_kg(const Params& p, int vb, int vg) {
    const float* ktab = (const float*)(p.ws + OFF_KTAB); bf16_t* KG = (bf16_t*)(p.ws + OFF_KG);
    const int k = otid(), s = k >> 4, j = k & 15;
    for (int row = vb; row < 32 * 512; row += vg) {
        const int g = row >> 9, m = row & 511, t = m >> 4, i = m & 15;
        const float* k0 = ktab + ((size_t)g * 2 + 0) * 32 * 256; const float* k1 = ktab + ((size_t)g * 2 + 1) * 32 * 256;
        float v;
        if (s < t) v = k0[(t - s) * 256 + i * 16 + j]; else if (s > t) v = k1[(s - t) * 256 + i * 16 + j]; else v = k0[i * 16 + j] + k1[i * 16 + j];
        KG[(size_t)row * 768 + k] = f2bf(v);
    }
}

__device__ __forceinline__ void phase_norm0(const Params& p) {
    const int tid_ = otid(); const int wid = tid_ >> 6, lane = tid_ & 63;
    const float* gw = PIN(4);
    bf16_t* A = (bf16_t*)(p.ws + OFF_A); float* rowsq = (float*)(p.ws + OFF_ROWSQ);
    const int half = gridDim.x * 8;
    for (int r = blockIdx.x * 8 + wid; r < MR; r += 2 * half) {
        const int r2 = (r + half < MR) ? r + half : r;
        const int b = r / LT, t = r - b * LT, b2 = r2 / LT, t2 = r2 - b2 * LT;
        const float* src = in_row(p, b, t); const float* src2 = in_row(p, b2, t2);
        const float* md = (const float*)(p.ws + OFF_MODS) + (size_t)(t < LC ? 4 : b) * 9216;
        const float* md2 = (const float*)(p.ws + OFF_MODS) + (size_t)(t2 < LC ? 4 : b2) * 9216;
        f32x4 v[4], w[4]; float ss = 0.f, ss2 = 0.f;
#pragma unroll
        for (int i = 0; i < 4; ++i) { v[i] = *(const f32x4*)(src + i * 256 + lane * 4); w[i] = *(const f32x4*)(src2 + i * 256 + lane * 4); }
#pragma unroll
        for (int i = 0; i < 4; ++i) { ss += v[i][0] * v[i][0] + v[i][1] * v[i][1] + v[i][2] * v[i][2] + v[i][3] * v[i][3]; ss2 += w[i][0] * w[i][0] + w[i][1] * w[i][1] + w[i][2] * w[i][2] + w[i][3] * w[i][3]; }
        for (int o = 32; o >= 1; o >>= 1) { ss += __shfl_xor(ss, o); ss2 += __shfl_xor(ss2, o); }
        if (lane == 0) { rowsq[r] = ss; if (r2 != r) rowsq[r2] = ss2; }
#pragma unroll
        for (int i = 0; i < 4; ++i) { const int c = i * 256 + lane * 4;
            const f32x4 g4 = *(const f32x4*)(gw + c), sc = *(const f32x4*)(md + 1024 + c), sc2 = *(const f32x4*)(md2 + 1024 + c);
            const f32x4 o = v[i] * g4 * (sc + 1.0f), o2 = w[i] * g4 * (sc2 + 1.0f);
            u32x2 q; q.x = cvt_pk_bf16(o[0], o[1]); q.y = cvt_pk_bf16(o[2], o[3]);
            *(u32x2*)(A + (size_t)r * DM + c) = q;
            if (r2 != r) { u32x2 q2; q2.x = cvt_pk_bf16(o2[0], o2[1]); q2.y = cvt_pk_bf16(o2[2], o2[3]); *(u32x2*)(A + (size_t)r2 * DM + c) = q2; } }
    }
}
__device__ __forceinline__ void p1_gam(const Params& p) {
    float* gam = (float*)(p.ws + OFF_GAM); const float* mods = (const float*)(p.ws + OFF_MODS); const float* ng = PIN(4);
    for (int i = blockIdx.x * 512 + otid(); i < 6 * 5 * 1024; i += gridDim.x * 512) {
        const int c = i & 1023, v = (i >> 10) % 5, j = i / 5120, l = j / 3, which = j % 3;
        gam[i] = ng[(size_t)j * 1024 + c] * (1.0f + mods[((size_t)l * 5 + v) * 9216 + (3 * which + 1) * 1024 + c]);
    }
}
template <int MAP> __device__ __forceinline__ void beta_gemv(const Params& p, const float* W, int N, int j, LAS float* sl, int& cbase, int vb, int vg) {
    const int tid = otid(), l = j / 3, which = j % 3;
    const float* mods = (const float*)(p.ws + OFF_MODS); float* beta = (float*)(p.ws + OFF_BETA) + (size_t)j * 5 * 5632;
    __syncthreads();
    for (int i = tid; i < 5 * 1024; i += 512) sl[i] = mods[((size_t)l * 5 + (i >> 10)) * 9216 + (3 * which) * 1024 + (i & 1023)];
    LAS float* red = sl + 5 * 1024;
    const int nch = N / 64;
    int first = vb - (cbase % vg); if (first < 0) first += vg;
    for (int chunk = first; chunk < nch; chunk += vg) {
        const int cl = tid & 63, kg = tid >> 6, np = chunk * 64 + cl;
        const float* w = W + colmap<MAP>(np);
        float a[5] = {0.f, 0.f, 0.f, 0.f, 0.f};
        __syncthreads();
        for (int k0 = kg * 128; k0 < kg * 128 + 128; k0 += 16) { float wv[16];
#pragma unroll
            for (int q = 0; q < 16; ++q) wv[q] = w[(size_t)(k0 + q) * N];
#pragma unroll
            for (int q = 0; q < 16; ++q)
#pragma unroll
                for (int v = 0; v < 5; ++v) a[v] += sl[v * 1024 + k0 + q] * wv[q]; }
#pragma unroll
        for (int v = 0; v < 5; ++v) red[(kg * 64 + cl) * 5 + v] = a[v];
        __syncthreads();
        if (tid < 320) { const int v = tid / 64, c2 = tid & 63; float sacc = 0.f;
#pragma unroll
            for (int q = 0; q < 8; ++q) sacc += red[(q * 64 + c2) * 5 + v];
            beta[(size_t)v * N + chunk * 64 + c2] = sacc; }
    }
    cbase += nch;
    __syncthreads();
}

__device__ __forceinline__ void phase_final(const Params& p) {
    const int tid_ = otid(); const int wid = tid_ >> 6, lane = tid_ & 63;
    const float* gw = PIN(35);
    const int half = gridDim.x * 8;
    for (int r = blockIdx.x * 8 + wid; r < NB * SEQ; r += 2 * half) {
        const int r2 = (r + half < NB * SEQ) ? r + half : r;
        float* row = p.out + (size_t)r * DM; float* row2 = p.out + (size_t)r2 * DM;
        f32x4 v[4], w[4]; float ss = 0.f, ss2 = 0.f;
#pragma unroll
        for (int i = 0; i < 4; ++i) { v[i] = *(const f32x4*)(row + i * 256 + lane * 4); w[i] = *(const f32x4*)(row2 + i * 256 + lane * 4); }
#pragma unroll
        for (int i = 0; i < 4; ++i) { ss += v[i][0] * v[i][0] + v[i][1] * v[i][1] + v[i][2] * v[i][2] + v[i][3] * v[i][3]; ss2 += w[i][0] * w[i][0] + w[i][1] * w[i][1] + w[i][2] * w[i][2] + w[i][3] * w[i][3]; }
        for (int o = 32; o >= 1; o >>= 1) { ss += __shfl_xor(ss, o); ss2 += __shfl_xor(ss2, o); }
        const float rstd = rsqrtf(ss * (1.0f / 1024.0f) + 1e-6f), rstd2 = rsqrtf(ss2 * (1.0f / 1024.0f) + 1e-6f);
#pragma unroll
        for (int i = 0; i < 4; ++i) { const int c = i * 256 + lane * 4; const f32x4 g4 = *(const f32x4*)(gw + c);
            *(f32x4*)(row + c) = v[i] * rstd * g4; if (r2 != r) *(f32x4*)(row2 + c) = w[i] * rstd2 * g4; }
    }
}

__device__ __forceinline__ void phase_mixprep(const Params& p) {
    const int tid_ = otid(); const int wid = tid_ >> 6, lane = tid_ & 63;
    const bf16_t* P = (const bf16_t*)(p.ws + OFF_P); bf16_t* AL = (bf16_t*)(p.ws + OFF_ALORA); bf16_t* UX = (bf16_t*)(p.ws + OFF_UX);
    const float* mu0 = PIN(11); const float* mu1 = PIN(11) + 1792;
    unsigned short* MIX = (unsigned short*)(p.ws + OFF_MIX);
    float m0c[3][8], m1c[3][8], kkc[8];
#pragma unroll
    for (int q = 0; q < 3; ++q)
#pragma unroll
        for (int e = 0; e < 8; ++e) { m0c[q][e] = mu0[q * 512 + lane * 8 + e]; m1c[q][e] = mu1[q * 512 + lane * 8 + e]; }
#pragma unroll
    for (int e = 0; e < 8; ++e) kkc[e] = PIN(17)[lane * 8 + e];
    for (int r = blockIdx.x * 8 + wid; r < MR; r += gridDim.x * 8) {
        const int b = r / LT, t = r - b * LT;
        const bool hp = (t != 0 && t != LC), hn = (t != LC - 1 && t != LT - 1);
        const bf16_t* pr = P + (size_t)r * 2304;
        const int c = 1536 + lane * 4;
        const u32x2 cw = *(const u32x2*)(pr + c);
        u32x2 pw = {0u, 0u}, nw = {0u, 0u};
        if (hp) pw = *(const u32x2*)(pr - 2304 + c);
        if (hn) nw = *(const u32x2*)(pr + 2304 + c);
        const f32x4 m0 = *(const f32x4*)(mu0 + c), m1 = *(const f32x4*)(mu1 + c);
        float x[4] = {lo_bf(cw.x), hi_bf(cw.x), lo_bf(cw.y), hi_bf(cw.y)};
        const float pv[4] = {lo_bf(pw.x), hi_bf(pw.x), lo_bf(pw.y), hi_bf(pw.y)}, nv[4] = {lo_bf(nw.x), hi_bf(nw.x), lo_bf(nw.y), hi_bf(nw.y)};
#pragma unroll
        for (int e = 0; e < 4; ++e) { const float v = x[e] + m0[e] * (pv[e] - x[e]) + m1[e] * (nv[e] - x[e]);
            x[e] = lane < 16 ? tanhf(v) : (lane < 32 ? v : sigmoidf_(v)); }
        u32x2 w; w.x = cvt_pk_bf16(x[0], x[1]); w.y = cvt_pk_bf16(x[2], x[3]);
        *(u32x2*)(AL + (size_t)r * 256 + lane * 4) = w;
        const u32x4 uw = *(const u32x4*)(pr + 1792 + lane * 8);
        const int g = lane >> 1, n = b * NCH + (t >> 5), tt = t & 31;
        *(u32x4*)(UX + ((size_t)g * NROWS_G + n) * 768 + tt * 16 + (lane & 1) * 8) = uw;
        const float fpv = hp ? 1.0f : 0.0f, fnv = hn ? 1.0f : 0.0f;
        float rk[3][8];
#pragma unroll
        for (int q = 0; q < 3; ++q) {
            const bf16_t* pq = pr + q * 512 + lane * 8;
            const u32x4 cq = *(const u32x4*)pq, pq4 = *(const u32x4*)(pq - (hp ? 2304 : 0)), nq4 = *(const u32x4*)(pq + (hn ? 2304 : 0));
            const unsigned ca[4] = {cq.x, cq.y, cq.z, cq.w}, pa[4] = {pq4.x, pq4.y, pq4.z, pq4.w}, na[4] = {nq4.x, nq4.y, nq4.z, nq4.w};
#pragma unroll
            for (int e = 0; e < 4; ++e) { const float c0 = lo_bf(ca[e]), c1 = hi_bf(ca[e]);
                rk[q][2 * e] = c0 + m0c[q][2 * e] * (fpv * lo_bf(pa[e]) - c0) + m1c[q][2 * e] * (fnv * lo_bf(na[e]) - c0);
                rk[q][2 * e + 1] = c1 + m0c[q][2 * e + 1] * (fpv * hi_bf(pa[e]) - c1) + m1c[q][2 * e + 1] * (fnv * hi_bf(na[e]) - c1); }
            u32x4 wq; wq.x = pk_h16(rk[q][0], rk[q][1]); wq.y = pk_h16(rk[q][2], rk[q][3]); wq.z = pk_h16(rk[q][4], rk[q][5]); wq.w = pk_h16(rk[q][6], rk[q][7]);
            *(u32x4*)(MIX + (size_t)q * MR * 512 + (size_t)r * 512 + lane * 8) = wq;
        }
        float kx[8], ss = 0.f;
#pragma unroll
        for (int e = 0; e < 8; ++e) { kx[e] = rk[1][e] * kkc[e]; ss += kx[e] * kx[e]; }
        ss += dpp_mov<0xB1>(ss); ss += dpp_mov<0x4E>(ss); ss += dpp_mov<0x141>(ss);
        const float rn = rsqrtf(fmaxf(ss, 1e-12f));
        u32x4 wk; wk.x = pk_h16(kx[0] * rn, kx[1] * rn); wk.y = pk_h16(kx[2] * rn, kx[3] * rn); wk.z = pk_h16(kx[4] * rn, kx[5] * rn); wk.w = pk_h16(kx[6] * rn, kx[7] * rn);
        *(u32x4*)(MIX + (size_t)3 * MR * 512 + (size_t)r * 512 + lane * 8) = wk;
    }
}

__device__ __forceinline__ void phase_s5carry(const Params& p) {
    const int tid_ = otid();
    if (tid_ >= 64) return;
    for (int gi = blockIdx.x * 64 + tid_; gi < NB * 32 * 2 * 64; gi += gridDim.x * 64) {
    const int pp = gi & 63, d = (gi >> 6) & 1, g = (gi >> 7) & 31, b = gi >> 12, gd = d * 32 + g;
    const float lre = fminf(PIN(22)[gd * 64 + pp], -1e-4f), lim = PIN(23)[gd * 64 + pp], dt = __expf(PIN(24)[gd]);
    const float mg = __expf(32.0f * lre * dt); float sn, cs; sincosf(32.0f * lim * dt, &sn, &cs);
    const float ar = mg * cs, ai = mg * sn;
    const float* E = (const float*)(p.ws + OFF_E); bf16_t* UX = (bf16_t*)(p.ws + OFF_UX);
    float xr = 0.f, xi = 0.f;
    for (int s0 = 0; s0 < NCH; s0 += 17) {
        f32x2 e[17]; size_t nn[17];
#pragma unroll
        for (int q = 0; q < 17; ++q) { const int s = s0 + q; const int c = d == 0 ? s : (s < 8 ? 7 - s : 143 - s);
            nn[q] = (size_t)g * NROWS_G + b * NCH + c; e[q] = *(const f32x2*)(E + nn[q] * 256 + d * 128 + 2 * pp); }
#pragma unroll
        for (int q = 0; q < 17; ++q) {
            *(unsigned*)(UX + nn[q] * 768 + 512 + d * 128 + 2 * pp) = cvt_pk_bf16(xr, xi);
            const float nr = ar * xr - ai * xi + e[q][0], ni = ar * xi + ai * xr + e[q][1];
            xr = nr; xi = ni;
        }
    }
    }
}

struct ScanBuf { float w[32][64]; unsigned kb[32][16][4], tr[32][16][4]; float vv[32][16]; };
constexpr int SCAN_YOFF = 2 * 26624;
struct ScanRaw { u32x4 c[4], aw, lw; };
struct ScanConst { float ka[8]; };
__device__ __forceinline__ int scan_tok(int d, int s) { return d == 0 ? s : (s < LC ? LC - 1 - s : (LT + LC - 1) - s); }
__device__ __forceinline__ void scan_issue(const Params& p, ScanRaw& R, int b, int h, int d, int chunk, int lt) {
    const unsigned short* MIX = (const unsigned short*)(p.ws + OFF_MIX);
    const unsigned short* AD = (const unsigned short*)(p.ws + OFF_LWA + (size_t)(2 + d) * SZ512);
    const unsigned short* LW = (const unsigned short*)(p.ws + OFF_LWA + (size_t)d * SZ512);
    const int tt = lt >> 3, cg = lt & 7, tok = scan_tok(d, chunk * 32 + tt);
    const size_t o = ((size_t)b * LT + tok) * 512 + h * 64 + cg * 8;
#pragma unroll
    for (int q = 0; q < 4; ++q) R.c[q] = *(const u32x4*)(MIX + (size_t)q * MR * 512 + o);
    R.aw = *(const u32x4*)(AD + o); R.lw = *(const u32x4*)(LW + o);
}
__device__ __forceinline__ void scan_finish(const ScanRaw& R, const ScanConst& C, LAS ScanBuf* sb, int rq, int lt, int d, int chunk) {
    const int tt = lt >> 3, cg = lt & 7;
    float rkv[4][8];
#pragma unroll
    for (int q = 0; q < 4; ++q) { const unsigned wa[4] = {R.c[q].x, R.c[q].y, R.c[q].z, R.c[q].w};
#pragma unroll
        for (int e = 0; e < 4; ++e) { rkv[q][2 * e] = lo_h(wa[e]); rkv[q][2 * e + 1] = hi_h(wa[e]); } }
    const unsigned awa[4] = {R.aw.x, R.aw.y, R.aw.z, R.aw.w}, lwa[4] = {R.lw.x, R.lw.y, R.lw.z, R.lw.w};
    float o_w[8], o_b[8], o_k[8];
#pragma unroll
    for (int e = 0; e < 8; ++e) {
        const float a = (e & 1) ? hi_h(awa[e >> 1]) : lo_h(awa[e >> 1]);
        const float lwv = (e & 1) ? hi_h(lwa[e >> 1]) : lo_h(lwa[e >> 1]);
        o_w[e] = __expf(lwv); o_b[e] = -rkv[3][e] * a;     o_k[e] = rkv[1][e] * (1.0f + (a - 1.0f) * C.ka[e]);
    }
    LAS float* d1 = &sb->w[tt][cg * 8];  *(LAS f32x4*)d1 = (f32x4){o_w[0], o_w[1], o_w[2], o_w[3]};     *(LAS f32x4*)(d1 + 4) = (f32x4){o_w[4], o_w[5], o_w[6], o_w[7]};
#pragma unroll
    for (int pc = 0; pc < 2; ++pc) {
        u32x4 kbv, trv;
        kbv.x = pk_h16(rkv[3][4 * pc], rkv[3][4 * pc + 1]); kbv.y = pk_h16(rkv[3][4 * pc + 2], rkv[3][4 * pc + 3]); kbv.z = pk_h16(o_b[4 * pc], o_b[4 * pc + 1]); kbv.w = pk_h16(o_b[4 * pc + 2], o_b[4 * pc + 3]);
        trv.x = pk_h16(o_k[4 * pc], o_k[4 * pc + 1]); trv.y = pk_h16(o_k[4 * pc + 2], o_k[4 * pc + 3]); trv.z = pk_h16(rkv[0][4 * pc], rkv[0][4 * pc + 1]); trv.w = pk_h16(rkv[0][4 * pc + 2], rkv[0][4 * pc + 3]);
        *(LAS u32x4*)&sb->kb[tt][2 * cg + pc][0] = kbv; *(LAS u32x4*)&sb->tr[tt][2 * cg + pc][0] = trv;
    }
    if ((cg >> 1) == rq) { LAS float* d5 = &sb->vv[tt][(cg & 1) * 8]; *(LAS f32x4*)d5 = (f32x4){rkv[2][0], rkv[2][1], rkv[2][2], rkv[2][3]}; *(LAS f32x4*)(d5 + 4) = (f32x4){rkv[2][4], rkv[2][5], rkv[2][6], rkv[2][7]}; }
}
__device__ __forceinline__ void scan_store_y(bf16_t* Y, const LAS float* yp, int b, int h, int d, int rq, int cy, int lt) {
    const int tt = lt >> 3, pr2 = lt & 7, tok = scan_tok(d, cy * 32 + tt);
    const LAS float* base = yp + (cy & 1) * 8192 + tt * 256;
    float o[2];
#pragma unroll
    for (int q = 0; q < 2; ++q) { const int row = pr2 * 2 + q; const LAS f32x4* v = (const LAS f32x4*)(base + (row >> 2) * 64 + (row & 3) * 16);
        const f32x4 a = v[0] + v[1] + v[2] + v[3]; o[q] = (a[0] + a[1]) + (a[2] + a[3]); }
    *(unsigned*)(Y + ((size_t)b * LT + tok) * 512 + h * 64 + rq * 16 + pr2 * 2) = cvt_pk_bf16(o[0], o[1]);
}
struct StepOps { f32x4 w4; u32x4 kb, tr; float vv; };
__device__ __forceinline__ void phase_scan(const Params& p, LAS unsigned char* lds) {
    const int tid = otid();
    LAS ScanBuf* sb = (LAS ScanBuf*)lds;
    LAS float* yp = (LAS float*)(lds + SCAN_YOFF);
    for (int qi = blockIdx.x; qi < 256; qi += gridDim.x) {
    const int xcd = qi & 7, j = qi >> 3, chain = xcd * 8 + (j >> 2), rq = j & 3;
    const int b = chain >> 4, h = (chain >> 1) & 7, d = chain & 1;
    bf16_t* Y = (bf16_t*)(p.ws + OFF_A) + (size_t)d * MR * 512;
    const bool loader = tid >= 256; const int lt = tid - 256;
    if (loader) {
        ScanConst C; ScanRaw R;
        { const int ch = h * 64 + (lt & 7) * 8;
#pragma unroll
          for (int e = 0; e < 8; ++e) C.ka[e] = PIN(18)[ch + e]; }
        scan_issue(p, R, b, h, d, 0, lt); scan_finish(R, C, sb, rq, lt, d, 0);
        ScanRaw R2;
        scan_issue(p, R, b, h, d, 1, lt);
        scan_issue(p, R2, b, h, d, 2, lt);
        LDS_BARRIER();
        for (int c = 0; c < NCH; c += 2) {
            const int c1 = c + 1, c2 = (c + 2 < NCH) ? c + 2 : NCH - 1, c3 = (c + 3 < NCH) ? c + 3 : NCH - 1, c4 = (c + 4 < NCH) ? c + 4 : NCH - 1, cm = c >= 1 ? c - 1 : 0;
            scan_finish(R, C, sb + (c1 & 1), rq, lt, d, c1);
            scan_issue(p, R, b, h, d, c3, lt);
            scan_store_y(Y, yp, b, h, d, rq, cm, lt);
            LDS_BARRIER();
            scan_finish(R2, C, sb + ((c + 2) & 1), rq, lt, d, c2);
            scan_issue(p, R2, b, h, d, c4, lt);
            scan_store_y(Y, yp, b, h, d, rq, c, lt);
            LDS_BARRIER();
        }
        scan_store_y(Y, yp, b, h, d, rq, NCH - 1, lt);
    } else {
        const int lane = tid & 63, wv = tid >> 6, rowl = lane >> 4, kq = lane & 15, row = wv * 4 + rowl;
        float s0 = 0.f, s1 = 0.f, s2 = 0.f, s3 = 0.f; float zf = 0.f; asm volatile("" : "+v"(zf));
        LDS_BARRIER();
#define SC_LOAD(o, st) do { o.w4 = *(const LAS f32x4*)&cb->w[st][kq * 4]; o.kb = *(const LAS u32x4*)&cb->kb[st][kq][0]; o.tr = *(const LAS u32x4*)&cb->tr[st][kq][0]; o.vv = cb->vv[st][row]; } while (0)
          \
#define SC_STEP(o, rp, st) do { \
        float t0 = mixlo(o.kb.x, s0, zf), q0 = mixlo(rp.z, s0, zf), t1 = mixhi(o.kb.x, s1, zf), q1 = mixhi(rp.z, s1, zf); \
        t0 = mixlo(o.kb.y, s2, t0); q0 = mixlo(rp.w, s2, q0); t1 = mixhi(o.kb.y, s3, t1); q1 = mixhi(rp.w, s3, q1); \
        const float p0 = s0 * o.w4[0], p1 = s1 * o.w4[1], p2 = s2 * o.w4[2], p3 = s3 * o.w4[3]; \
        const float u0 = mixlo(o.tr.x, o.vv, p0), u1 = mixhi(o.tr.x, o.vv, p1), u2 = mixlo(o.tr.y, o.vv, p2), u3 = mixhi(o.tr.y, o.vv, p3); \
        const float sk = allreduce16(t0 + t1); \
        if ((st) > 0) yo[((st) - 1) * 256 + (tid & 255)] = q0 + q1; \
        s0 = mixlo(o.kb.z, sk, u0); s1 = mixhi(o.kb.z, sk, u1); s2 = mixlo(o.kb.w, sk, u2); s3 = mixhi(o.kb.w, sk, u3); } while (0)
        for (int c = 0; c < NCH; ++c) {
            const LAS ScanBuf* cb = sb + (c & 1);
            LAS float* yo = yp + (c & 1) * 8192;
            StepOps A, B, C4, D4;
            D4.tr = (u32x4){0u, 0u, 0u, 0u};
            SC_LOAD(A, 0); SC_LOAD(B, 1);
#pragma unroll
            for (int st = 0; st < 32; st += 4) {
                SC_LOAD(C4, st + 2); SC_STEP(A, D4.tr, st);
                SC_LOAD(D4, st + 3); SC_STEP(B, A.tr, st + 1);
                if (st + 4 < 32) SC_LOAD(A, st + 4);
                SC_STEP(C4, B.tr, st + 2);
                if (st + 5 < 32) SC_LOAD(B, st + 5);
                SC_STEP(D4, C4.tr, st + 3);
            }
            { const float q0 = mixlo(D4.tr.w, s2, mixlo(D4.tr.z, s0, zf)), q1 = mixhi(D4.tr.w, s3, mixhi(D4.tr.z, s1, zf)); yo[31 * 256 + (tid & 255)] = q0 + q1; }
            LDS_BARRIER();
        }
#undef SC_LOAD
#undef SC_STEP
    }
    __syncthreads();
    }
}

__device__ __forceinline__ void phase_rwkvpost(const Params& p) {
    const int tid_ = otid(); const int wid = tid_ >> 6, lane = tid_ & 63, sub = lane >> 4, l16 = lane & 15;
    const bf16_t* P = (const bf16_t*)(p.ws + OFF_P);
    const unsigned short* A0 = (const unsigned short*)(p.ws + OFF_LWA + 2 * SZ512); const unsigned short* A1 = (const unsigned short*)(p.ws + OFF_LWA + 3 * SZ512);
    const unsigned short* MIXP = (const unsigned short*)(p.ws + OFF_MIX);
    const unsigned short* G = (const unsigned short*)(p.ws + OFF_G);
    const bf16_t* Y0 = (const bf16_t*)(p.ws + OFF_A); const bf16_t* Y1 = Y0 + (size_t)MR * 512;
    bf16_t* CAT = (bf16_t*)(p.ws + OFF_CAT);
    const float* mu_ = PIN(11); const float* ka_ = PIN(18); const float* rk_ = PIN(19); const float* lg_ = PIN(20); const float* lb_ = PIN(21);
    struct PostIn { u32x2 c[3], a0w, a1w, gw, y0w, y1w; };
    if (wid == 0) return;
    const int stride = gridDim.x * 28, it0 = (blockIdx.x * 7 + (wid - 1)) * 4 + sub;
#define POST_LOAD(D, IT) do { const int r_ = (IT) >> 3, ch_ = ((IT) & 7) * 64 + l16 * 4; const size_t o_ = (size_t)r_ * 512 + ch_; \
        D.c[0] = *(const u32x2*)(MIXP + o_); D.c[1] = *(const u32x2*)(MIXP + (size_t)MR * 512 + o_); D.c[2] = *(const u32x2*)(MIXP + (size_t)2 * MR * 512 + o_); \
        D.a0w = *(const u32x2*)(A0 + o_); D.a1w = *(const u32x2*)(A1 + o_); D.gw = *(const u32x2*)(G + o_); D.y0w = *(const u32x2*)(Y0 + o_); D.y1w = *(const u32x2*)(Y1 + o_); } while (0)
    PostIn cur; if (it0 < MR * 8) POST_LOAD(cur, it0);
    for (int it = it0; it < MR * 8; it += stride) {
        PostIn nxt = cur; if (it + stride < MR * 8) POST_LOAD(nxt, it + stride);
        const int r = it >> 3, h = it & 7;
        const int ch = h * 64 + l16 * 4;
        float rkv[3][4];
#pragma unroll
        for (int q = 0; q < 3; ++q) { rkv[q][0] = lo_h(cur.c[q].x); rkv[q][1] = hi_h(cur.c[q].x); rkv[q][2] = lo_h(cur.c[q].y); rkv[q][3] = hi_h(cur.c[q].y); }
        const u32x2 a0w = cur.a0w, a1w = cur.a1w, gw = cur.gw, y0w = cur.y0w, y1w = cur.y1w;
        const f32x4 ka = *(const f32x4*)(ka_ + ch), rk = *(const f32x4*)(rk_ + ch), lg = *(const f32x4*)(lg_ + ch), lb = *(const f32x4*)(lb_ + ch);
        const float a0[4] = {lo_h(a0w.x), hi_h(a0w.x), lo_h(a0w.y), hi_h(a0w.y)}, a1[4] = {lo_h(a1w.x), hi_h(a1w.x), lo_h(a1w.y), hi_h(a1w.y)}, gg[4] = {lo_h(gw.x), hi_h(gw.x), lo_h(gw.y), hi_h(gw.y)};
        const float y[4] = {lo_bf(y0w.x) + lo_bf(y1w.x), hi_bf(y0w.x) + hi_bf(y1w.x), lo_bf(y0w.y) + lo_bf(y1w.y), hi_bf(y0w.y) + hi_bf(y1w.y)};
        float sy = 0.f, sb = 0.f;
#pragma unroll
        for (int e = 0; e < 4; ++e) { const float ksum = rkv[1][e] * (2.0f + (a0[e] + a1[e] - 2.0f) * ka[e]); sy += y[e]; sb += rkv[0][e] * 0.5f * ksum * rk[e]; }
        const float mu = allreduce16(sy) * (1.0f / 64.0f), bs = allreduce16(sb);
        float sv = 0.f, dv[4];
#pragma unroll
        for (int e = 0; e < 4; ++e) { dv[e] = y[e] - mu; sv += dv[e] * dv[e]; }
        const float rstd = rsqrtf(allreduce16(sv) * (1.0f / 64.0f) + 64e-5f);
        float o[4];
#pragma unroll
        for (int e = 0; e < 4; ++e) o[e] = (dv[e] * rstd * lg[e] + lb[e] + bs * rkv[2][e]) * gg[e];
        u32x2 w; w.x = cvt_pk_bf16(o[0], o[1]); w.y = cvt_pk_bf16(o[2], o[3]);
        *(u32x2*)(CAT + (size_t)r * DM + ch) = w;
        cur = nxt;
    }
#undef POST_LOAD
}

__device__ __forceinline__ void phase_attn(const Params& p, LAS unsigned char* lds) {
    const int tid = otid(), wv = tid >> 6, lane = tid & 63, fr = lane & 15, fq = lane >> 4;
    const bf16_t* Q = (const bf16_t*)(p.ws + OFF_Q); const bf16_t* Kb = (const bf16_t*)(p.ws + OFF_K); const bf16_t* Vb = (const bf16_t*)(p.ws + OFF_V);
    bf16_t* O = (bf16_t*)(p.ws + OFF_O);
    LAS bf16_t* KL = (LAS bf16_t*)lds;
    LAS bf16_t* VL = (LAS bf16_t*)(lds + 2 * 64 * 72 * 2);
    for (int item = blockIdx.x; item < 1024; item += gridDim.x) {
        const int qt = item & 63, kvh = (item >> 6) & 3, b = item >> 8;
        const int i0 = qt * 64, hq = kvh * 4 + (wv >> 1), qsub = (wv & 1) * 32;
        const int wlo = (2 - qt) > 0 ? (2 - qt) : 0, whi = (65 - qt) < 4 ? (65 - qt) : 4, ntl = 4 + (whi - wlo + 1);
#define TL_POS(ti) ((ti) < 4 ? -100000 : i0 - 128 + 64 * (wlo + (ti) - 4))
#define TL_ROW(ti) ((ti) < 4 ? b * LT + (ti) * 64 : b * LT + LC + i0 - 128 + 64 * (wlo + (ti) - 4))
        bf16x8 qf[2][2];
#pragma unroll
        for (int mt = 0; mt < 2; ++mt)
#pragma unroll
            for (int ks = 0; ks < 2; ++ks) qf[mt][ks] = *(const bf16x8*)(Q + ((size_t)b * LT + LC + i0 + qsub + mt * 16 + fr) * DM + hq * 64 + ks * 32 + fq * 8);
        f32x4 oacc[2][4];
#pragma unroll
        for (int mt = 0; mt < 2; ++mt)
#pragma unroll
            for (int dt = 0; dt < 4; ++dt) oacc[mt][dt] = (f32x4){0.f, 0.f, 0.f, 0.f};
        const float sink = PIN(34)[hq];
        float mrun[2] = {sink, sink}, lrun[2] = {fq == 0 ? 1.0f : 0.0f, fq == 0 ? 1.0f : 0.0f};
        const int skey = tid >> 3, sdg = tid & 7;
        u32x4 kreg = *(const u32x4*)(Kb + (size_t)(TL_ROW(0) + skey) * 256 + kvh * 64 + sdg * 8);
        u32x4 vreg = *(const u32x4*)(Vb + (size_t)(TL_ROW(0) + skey) * 256 + kvh * 64 + sdg * 8);
        LDS_BARRIER();
        for (int ti = 0; ti < ntl; ++ti) {
            LAS bf16_t* kl = KL + (ti & 1) * 64 * 72; LAS bf16_t* vl = VL + (ti & 1) * 64 * 72;
            *(LAS u32x4*)(kl + skey * 72 + sdg * 8) = kreg;
            { const unsigned va[4] = {vreg.x, vreg.y, vreg.z, vreg.w};
#pragma unroll
              for (int e = 0; e < 4; ++e) { vl[(sdg * 8 + 2 * e) * 72 + skey] = (bf16_t)(va[e] & 0xffffu); vl[(sdg * 8 + 2 * e + 1) * 72 + skey] = (bf16_t)(va[e] >> 16); } }
            if (ti + 1 < ntl) { kreg = *(const u32x4*)(Kb + (size_t)(TL_ROW(ti + 1) + skey) * 256 + kvh * 64 + sdg * 8); vreg = *(const u32x4*)(Vb + (size_t)(TL_ROW(ti + 1) + skey) * 256 + kvh * 64 + sdg * 8); }
            LDS_BARRIER();
            const int pos0 = TL_POS(ti);
            const bool edge = pos0 >= 0 && (pos0 < i0 - 64 || pos0 > i0 + 64);
            f32x4 sacc[2][4];
#pragma unroll
            for (int mt = 0; mt < 2; ++mt)
#pragma unroll
                for (int kt = 0; kt < 4; ++kt) sacc[mt][kt] = (f32x4){0.f, 0.f, 0.f, 0.f};
#pragma unroll
            for (int kt = 0; kt < 4; ++kt)
#pragma unroll
                for (int ks = 0; ks < 2; ++ks) { const bf16x8 kf = *(const LAS bf16x8*)(kl + (kt * 16 + fr) * 72 + ks * 32 + fq * 8);
#pragma unroll
                    for (int mt = 0; mt < 2; ++mt) sacc[mt][kt] = __builtin_amdgcn_mfma_f32_16x16x32_bf16(kf, qf[mt][ks], sacc[mt][kt], 0, 0, 0); }
            bf16x8 pb[2][2];
#pragma unroll
            for (int mt = 0; mt < 2; ++mt) {
                const int qi = i0 + qsub + mt * 16 + fr;
                float mx = -3.0e38f;
#pragma unroll
                for (int kt = 0; kt < 4; ++kt)
#pragma unroll
                    for (int jj = 0; jj < 4; ++jj) { const int kp = pos0 + kt * 16 + fq * 4 + jj; const int dlt = kp - qi;
                        float s = sacc[mt][kt][jj]; if (edge && (dlt > 128 || dlt < -128)) s = -1.0e30f; sacc[mt][kt][jj] = s; mx = fmaxf(mx, s); }
                mx = fmaxf(mx, __shfl_xor(mx, 16)); mx = fmaxf(mx, __shfl_xor(mx, 32));
                const float mnew = fmaxf(mrun[mt], mx), scl = __expf(mrun[mt] - mnew);
                mrun[mt] = mnew; float ls = 0.f;
                float pv[4][4];
#pragma unroll
                for (int kt = 0; kt < 4; ++kt)
#pragma unroll
                    for (int jj = 0; jj < 4; ++jj) { const float e = __expf(sacc[mt][kt][jj] - mnew); pv[kt][jj] = e; ls += e; }
                lrun[mt] = lrun[mt] * scl + ls;
#pragma unroll
                for (int dt = 0; dt < 4; ++dt) oacc[mt][dt] *= scl;
#pragma unroll
                for (int k2 = 0; k2 < 2; ++k2) { u32x4 w; w.x = cvt_pk_bf16(pv[2 * k2][0], pv[2 * k2][1]); w.y = cvt_pk_bf16(pv[2 * k2][2], pv[2 * k2][3]);
                    w.z = cvt_pk_bf16(pv[2 * k2 + 1][0], pv[2 * k2 + 1][1]); w.w = cvt_pk_bf16(pv[2 * k2 + 1][2], pv[2 * k2 + 1][3]); pb[mt][k2] = __builtin_bit_cast(bf16x8, w); }
            }
#pragma unroll
            for (int dt = 0; dt < 4; ++dt)
#pragma unroll
                for (int k2 = 0; k2 < 2; ++k2) { const LAS bf16_t* vp = vl + (dt * 16 + fr) * 72 + k2 * 32 + fq * 4;
                    const u32x2 lo = *(const LAS u32x2*)vp, hi = *(const LAS u32x2*)(vp + 16);
                    const u32x4 vw = {lo.x, lo.y, hi.x, hi.y}; const bf16x8 vf = __builtin_bit_cast(bf16x8, vw);
#pragma unroll
                    for (int mt = 0; mt < 2; ++mt) oacc[mt][dt] = __builtin_amdgcn_mfma_f32_16x16x32_bf16(vf, pb[mt][k2], oacc[mt][dt], 0, 0, 0); }
        }
#pragma unroll
        for (int mt = 0; mt < 2; ++mt) {
            float l = lrun[mt]; l += __shfl_xor(l, 16); l += __shfl_xor(l, 32);
            const float inv = 1.0f / l;
            bf16_t* op = O + ((size_t)b * LT + LC + i0 + qsub + mt * 16 + fr) * DM + hq * 64 + fq * 4;
#pragma unroll
            for (int dt = 0; dt < 4; ++dt) { const f32x4 o = oacc[mt][dt] * inv; u32x2 w; w.x = cvt_pk_bf16(o[0], o[1]); w.y = cvt_pk_bf16(o[2], o[3]); *(u32x2*)(op + dt * 16) = w; }
        }
    }
    __syncthreads();
}

__global__ void __launch_bounds__(512, 2) fwd_kernel(Params p) {
    extern __shared__ __attribute__((aligned(16))) unsigned char lds_raw[];
    LAS unsigned char* lds = (LAS unsigned char*)lds_raw;
    volatile LAS unsigned* misc = (volatile LAS unsigned*)(lds + MISC_OFF);
    if (threadIdx.x < 4) misc[threadIdx.x] = 0u;
    __syncthreads();
    XcdBarrier bar; bar.bar = (unsigned*)(p.ws + OFF_BAR); bar.x = 0; bar.st = misc;
    const bool one = (p.ph_hi - p.ph_lo) > 1;
    if (one) bar = xcd_barrier_post((unsigned*)(p.ws + OFF_BAR), misc);
    unsigned char* ws = p.ws;
    const int G = gridDim.x, cidx = blockIdx.x;
    const float* mods0 = (const float*)(ws + OFF_MODS); const float* mods1 = mods0 + 5 * 9216;
    float* XC = (float*)(ws + OFF_XC);
    int ph = 0;
#define PH_BEGIN if (ph >= p.ph_lo && ph < p.ph_hi) { for (int rep_ = 0; rep_ <= (int)((REP_MASK >> ph) & 1u); ++rep_) {
#define PH_END   if (ph + 1 < p.ph_hi) xcd_barrier(bar); } } ++ph;

    PH_BEGIN
        LAS float* sl = (LAS float*)lds;
        int tb = 0;
        for (int f = 0; f < 1; ++f) convert_T<1>(PIN(7) + (size_t)f * DM * 5632, DM, 5632, 5632, (bf16_t*)(ws + OFF_W1T0 + f * SZ_W1T), DM, sl, tb, (int)blockIdx.x, (int)gridDim.x);
        for (int f = 0; f < 1; ++f) convert_T<0>(PIN(8) + (size_t)f * DFF * DM, DFF, DM, DM, (bf16_t*)(ws + OFF_W2T0 + f * SZ_W2T), DFF, sl, tb, (int)blockIdx.x, (int)gridDim.x);
        convert_T<0>(PIN(9), DM, 2304, 2304, (bf16_t*)(ws + OFF_ABIN), DM, sl, tb, (int)blockIdx.x, (int)gridDim.x);
        convert_T<0>(PIN(10), DM, DM, DM, (bf16_t*)(ws + OFF_ABOUT), DM, sl, tb, (int)blockIdx.x, (int)gridDim.x);
        convert_T<0>(PIN(30), 512, 512, 512, (bf16_t*)(ws + OFF_GLU), 512, sl, tb, (int)blockIdx.x, (int)gridDim.x);
        for (int d = 0; d < 2; ++d) convert_T<0>(PIN(13) + (size_t)d * 64 * 512, 64, 512, 512, (bf16_t*)(ws + OFF_LORA) + (size_t)d * 512 * 256, 256, sl, tb, (int)blockIdx.x, (int)gridDim.x);
        for (int d = 0; d < 2; ++d) convert_T<0>(PIN(15) + (size_t)d * 64 * 512, 64, 512, 512, (bf16_t*)(ws + OFF_LORA) + (size_t)(1024 + d * 512) * 256 + 64, 256, sl, tb, (int)blockIdx.x, (int)gridDim.x);
        convert_T<0>(PIN(16), 128, 512, 512, (bf16_t*)(ws + OFF_LORA) + (size_t)2048 * 256 + 128, 256, sl, tb, (int)blockIdx.x, (int)gridDim.x);
        __syncthreads();
        p0_mods(p, sl);
        p0_rope(p);
        p0_s5ops(p, sl);
    PH_END
    PH_BEGIN
        phase_norm0(p); p1_gam(p);
        { LAS float* sl = (LAS float*)lds; int cb = 0; beta_gemv<1>(p, PIN(7), 5632, 0, sl, cb, (int)blockIdx.x, (int)gridDim.x); }
    PH_END
    float* RSQ = (float*)(ws + OFF_ROWSQ); const float* GAM = (const float*)(ws + OFF_GAM); const float* BETA = (const float*)(ws + OFF_BETA);
    bf16_t* ABUF = (bf16_t*)(ws + OFF_A);
#define RSQJ(j) (RSQ + (size_t)(j) * MR)
#define GAMJ(j) (GAM + (size_t)(j) * 5 * 1024)
#define BETAJ(j) (BETA + (size_t)(j) * 5 * 5632)
    PH_BEGIN { pg8::Gemm g{(const bf16_t*)(ws + OFF_A), (const bf16_t*)(ws + OFF_W1T0), DM, DM, DM}; pg8::Sched S; S.init(0, 68, 22, 1, 0, G, cidx);
               pg8::EpiSwiglu E{(bf16_t*)(ws + OFF_ACT), RSQJ(0), BETAJ(0)}; pg8::gemm_phase(lds, g, S, E); } PH_END
    PH_BEGIN { pg8::Gemm g{(const bf16_t*)(ws + OFF_ACT), (const bf16_t*)(ws + OFF_W2T0), DFF, DFF, DFF}; pg8::Sched S; S.init(0, 68, 4, 1, 0, G, cidx);
               pg8::EpiResid<true, true> E{PIN(0), PIN(2), p.out, XC, mods0, 2, ABUF, GAMJ(1), RSQJ(1)}; pg8::gemm_phase(lds, g, S, E); }
             {
               LAS float* sl = (LAS float*)lds; unsigned* ctr = (unsigned*)(ws + OFF_BAR) + 3520; int vb;
               while ((vb = next_ticket(ctr, misc + 8)) < 580) { int cb = 0; const int BIG = 1 << 20;
                   if (vb < 36) beta_gemv<0>(p, PIN(9), 2304, 1, sl, cb, vb, BIG);
                   else if (vb < 124) beta_gemv<1>(p, PIN(7) + (size_t)1 * DM * 5632, 5632, 2, sl, cb, vb - 36, BIG);
                   else if (vb < 212) beta_gemv<1>(p, PIN(7) + (size_t)2 * DM * 5632, 5632, 3, sl, cb, vb - 124, BIG);
                   else if (vb < 236) beta_gemv<2>(p, PIN(32), 1536, 4, sl, cb, vb - 212, BIG);
                   else if (vb < 324) beta_gemv<1>(p, PIN(7) + (size_t)3 * DM * 5632, 5632, 5, sl, cb, vb - 236, BIG);
                   else p1_kg(p, vb - 324, 256); } }
    PH_END
    PH_BEGIN { pg8::Gemm g{(const bf16_t*)(ws + OFF_A), (const bf16_t*)(ws + OFF_ABIN), DM, DM, DM}; pg8::Sched S; S.init(0, 68, 9, 1, 0, G, cidx);
               pg8::EpiStoreBf16 E{(bf16_t*)(ws + OFF_P), 2304, RSQJ(1), BETAJ(1), 2304}; pg8::gemm_phase(lds, g, S, E); } PH_END
    PH_BEGIN phase_mixprep(p); PH_END
    PH_BEGIN { { pg8::Gemm g{(const bf16_t*)(ws + OFF_ALORA), (const bf16_t*)(ws + OFF_LORA), 256, 256, 256}; pg8::Sched S; S.init(0, 68, 10, 1, 0, G, cidx);
                 pg8::EpiLora E{ws, PIN(12), PIN(14)}; pg8::gemm_phase(lds, g, S, E); }
               { pg8::Gemm g{(const bf16_t*)(ws + OFF_UX), (const bf16_t*)(ws + OFF_F), 512, 768, 512}; pg8::Sched S; S.init(2, 3, 1, 32, 256, G, cidx);
                 pg8::EpiE E{(float*)(ws + OFF_E)}; pg8::gemm_phase(lds, g, S, E); } } PH_END
    PH_BEGIN phase_scan(p, lds); PH_END
    PH_BEGIN phase_s5carry(p); phase_rwkvpost(p); PH_END
    PH_BEGIN { pg8::Gemm g{(const bf16_t*)(ws + OFF_UX), (const bf16_t*)(ws + OFF_KG), 768, 768, 768}; pg8::Sched S; S.init(2, 3, 2, 32, 512, G, cidx);
               pg8::EpiY E{(const bf16_t*)(ws + OFF_UX), PIN(29), (bf16_t*)(ws + OFF_A)}; pg8::gemm_phase(lds, g, S, E); } PH_END
    PH_BEGIN { pg8::Gemm g{(const bf16_t*)(ws + OFF_A), (const bf16_t*)(ws + OFF_GLU), 512, 512, 512}; pg8::Sched S; S.init(0, 68, 2, 1, 0, G, cidx);
               pg8::EpiGlu E{(const bf16_t*)(ws + OFF_A), PIN(31), (bf16_t*)(ws + OFF_CAT)}; pg8::gemm_phase(lds, g, S, E); } PH_END
    PH_BEGIN { pg8::Gemm g{(const bf16_t*)(ws + OFF_CAT), (const bf16_t*)(ws + OFF_ABOUT), DM, DM, DM}; pg8::Sched S; S.init(0, 68, 4, 1, 0, G, cidx);
               pg8::EpiResid<false, true> E{p.out, XC, p.out, XC, mods0, 5, ABUF, GAMJ(2), RSQJ(2)}; pg8::gemm_phase(lds, g, S, E); }
             {
               LAS float* sl = (LAS float*)lds; unsigned* ctr = (unsigned*)(ws + OFF_BAR) + 3648; int vb;
               while ((vb = next_ticket(ctr, misc + 8)) < 512) { int tb = 0;
                   convert_T<1>(PIN(7) + (size_t)1 * DM * 5632, DM, 5632, 5632, (bf16_t*)(ws + OFF_W1T0 + SZ_W1T), DM, sl, tb, vb, 512);
                   convert_T<0>(PIN(8) + (size_t)1 * DFF * DM, DFF, DM, DM, (bf16_t*)(ws + OFF_W2T0 + SZ_W2T), DFF, sl, tb, vb, 512); } }
    PH_END
    PH_BEGIN
        { pg8::Gemm g{(const bf16_t*)(ws + OFF_A), (const bf16_t*)(ws + OFF_W1T0 + SZ_W1T), DM, DM, DM}; pg8::Sched S; S.init(0, 68, 22, 1, 0, G, cidx);
          pg8::EpiSwiglu E{(bf16_t*)(ws + OFF_ACT), RSQJ(2), BETAJ(2)}; pg8::gemm_phase(lds, g, S, E); }
    PH_END
    PH_BEGIN { pg8::Gemm g{(const bf16_t*)(ws + OFF_ACT), (const bf16_t*)(ws + OFF_W2T0 + SZ_W2T), DFF, DFF, DFF}; pg8::Sched S; S.init(0, 68, 4, 1, 0, G, cidx);
               pg8::EpiResid<true, true> E{p.out, XC, p.out, XC, mods0, 8, ABUF, GAMJ(3), RSQJ(3)}; pg8::gemm_phase(lds, g, S, E); }
             {
               LAS float* sl = (LAS float*)lds; unsigned* ctr = (unsigned*)(ws + OFF_BAR) + 3584; int vb;
               while ((vb = next_ticket(ctr, misc + 8)) < 1024) { int tb = 0;
                   for (int f = 0; f < 2; ++f) convert_T<1>(PIN(7) + (size_t)(2 + f) * DM * 5632, DM, 5632, 5632, (bf16_t*)(ws + OFF_W1T1 + f * SZ_W1T), DM, sl, tb, vb, 1024);
                   for (int f = 0; f < 2; ++f) convert_T<0>(PIN(8) + (size_t)(2 + f) * DFF * DM, DFF, DM, DM, (bf16_t*)(ws + OFF_W2T1 + f * SZ_W2T), DFF, sl, tb, vb, 1024);
                   convert_T<2>(PIN(32), DM, 1536, 1536, (bf16_t*)(ws + OFF_ATTNIN), DM, sl, tb, vb, 1024);
                   convert_T<0>(PIN(33), DM, DM, DM, (bf16_t*)(ws + OFF_ATTNOUT), DM, sl, tb, vb, 1024); } }
    PH_END
    PH_BEGIN { pg8::Gemm g{(const bf16_t*)(ws + OFF_A), (const bf16_t*)(ws + OFF_W1T1), DM, DM, DM}; pg8::Sched S; S.init(0, 68, 22, 1, 0, G, cidx);
               pg8::EpiSwiglu E{(bf16_t*)(ws + OFF_ACT), RSQJ(3), BETAJ(3)}; pg8::gemm_phase(lds, g, S, E); } PH_END
    PH_BEGIN { pg8::Gemm g{(const bf16_t*)(ws + OFF_ACT), (const bf16_t*)(ws + OFF_W2T1), DFF, DFF, DFF}; pg8::Sched S; S.init(0, 68, 4, 1, 0, G, cidx);
               pg8::EpiResid<true, true> E{p.out, XC, p.out, XC, mods1, 2, ABUF, GAMJ(4), RSQJ(4)}; pg8::gemm_phase(lds, g, S, E); } PH_END
    PH_BEGIN { pg8::Gemm g{(const bf16_t*)(ws + OFF_A), (const bf16_t*)(ws + OFF_ATTNIN), DM, DM, DM}; pg8::Sched S; S.init(0, 68, 6, 1, 0, G, cidx);
               pg8::EpiQKV E{(bf16_t*)(ws + OFF_Q), (bf16_t*)(ws + OFF_K), (bf16_t*)(ws + OFF_V), (const float*)(ws + OFF_ROPE), RSQJ(4), BETAJ(4)}; pg8::gemm_phase(lds, g, S, E); } PH_END
    PH_BEGIN phase_attn(p, lds); PH_END
    PH_BEGIN { pg8::Gemm g{(const bf16_t*)(ws + OFF_O), (const bf16_t*)(ws + OFF_ATTNOUT), DM, DM, DM}; pg8::Sched S; S.init(1, 64, 4, 1, 0, G, cidx);
               pg8::EpiResid<false, true> E{p.out, XC, p.out, XC, mods1, 5, ABUF, GAMJ(5), RSQJ(5)}; pg8::gemm_phase(lds, g, S, E); } PH_END
    PH_BEGIN { pg8::Gemm g{(const bf16_t*)(ws + OFF_A), (const bf16_t*)(ws + OFF_W1T1 + SZ_W1T), DM, DM, DM}; pg8::Sched S; S.init(1, 64, 22, 1, 0, G, cidx);
               pg8::EpiSwiglu E{(bf16_t*)(ws + OFF_ACT), RSQJ(5), BETAJ(5)}; pg8::gemm_phase(lds, g, S, E); } PH_END
    PH_BEGIN { pg8::Gemm g{(const bf16_t*)(ws + OFF_ACT), (const bf16_t*)(ws + OFF_W2T1 + SZ_W2T), DFF, DFF, DFF}; pg8::Sched S; S.init(1, 64, 4, 1, 0, G, cidx);
               pg8::EpiResid<true, false> E{p.out, XC, p.out, XC, mods1, 8, ABUF, GAMJ(0), RSQJ(6)}; pg8::gemm_phase(lds, g, S, E); } PH_END
    PH_BEGIN phase_final(p); PH_END
}
constexpr int N_PHASES = 22;

extern "C" void kernel_launch(void* const* d_in, const int* in_sizes, int n_in, void* d_out, int out_size, void* d_ws, size_t ws_size, hipStream_t stream) {
    static int grid = 0;
    if (grid == 0) {
        if (n_in != 36 || ws_size < WS_NEED) { fprintf(stderr, "kernel_launch: need 36 inputs and %zu bytes of workspace (got %d, %zu)\n", (size_t)WS_NEED, n_in, ws_size); grid = -1; return; }
        int dev = 0, cus = 0;
        if (hipGetDevice(&dev) != hipSuccess || hipDeviceGetAttribute(&cus, hipDeviceAttributeMultiprocessorCount, dev) != hipSuccess) { grid = -1; return; }
        if (hipFuncSetAttribute((const void*)fwd_kernel, hipFuncAttributeMaxDynamicSharedMemorySize, LDS_BYTES) != hipSuccess) { fprintf(stderr, "kernel_launch: hipFuncSetAttribute failed\n"); grid = -1; return; }
        int per_cu = 0; (void)hipOccupancyMaxActiveBlocksPerMultiprocessor(&per_cu, (const void*)fwd_kernel, 512, LDS_BYTES); (void)hipGetLastError();
        grid = cus < 256 ? cus : 256;
    }
    if (grid < 0) return;
    (void)hipMemsetAsync((char*)d_ws + OFF_BAR, 0, OFF_XC, stream);
    Params p{};
    for (int i = 0; i < 36; ++i) p.in[i] = (const float*)d_in[i];
    p.out = (float*)d_out; p.ws = (unsigned char*)d_ws;
#if N_LAUNCH_MODE == 1
    p.ph_lo = 0; p.ph_hi = N_PHASES;
    hipLaunchKernelGGL(fwd_kernel, dim3(grid), dim3(512), LDS_BYTES, stream, p);
#else
    for (int i = 0; i < N_PHASES; ++i) { p.ph_lo = i; p.ph_hi = i + 1; hipLaunchKernelGGL(fwd_kernel, dim3(grid), dim3(512), LDS_BYTES, stream, p); }
#endif
}
```
